# Optimizing an MI355X kernel written in HIP

```python
import math
import jax
import jax.numpy as jnp
from jax import lax
import numpy as np

D_MODEL = 1024
BATCH = 2
SEQ = 8192
DEPTH = 2

GRID_W = 64
CTX_LEN = 256
W_BRANCH = 256
N_BRANCH = 4
S5_GROUP = 16
S5_GROUPS = W_BRANCH // S5_GROUP
S5_STATE = 64
FNET_GROUPS = 4
POOL_WINDOWS = (2, 4, 8, 16)
CONV_WIDTH = 31
D_FF = 4 * D_MODEL
D_IN = 5 * W_BRANCH + N_BRANCH * D_MODEL
N_MOD = 6
EPS = 1e-6
POS_BASE = 10000.0

kernel_name = 'hybrid_s5_fnet_pool_conformer_dit'


def _rms_norm(x, g):
    xf = x.astype(jnp.float32)
    y = xf * lax.rsqrt(jnp.mean(xf * xf, axis=-1, keepdims=True) + EPS)
    return (y * g.astype(jnp.float32)).astype(x.dtype)


def _layer_norm(x, g, b):
    xf = x.astype(jnp.float32)
    mu = jnp.mean(xf, axis=-1, keepdims=True)
    xc = xf - mu
    y = xc * lax.rsqrt(jnp.mean(xc * xc, axis=-1, keepdims=True) + EPS)
    return (y * g.astype(jnp.float32) + b.astype(jnp.float32)).astype(x.dtype)


def _modulate(x, g, shift, scale):
    return _rms_norm(x, g) * (1 + scale) + shift


def _pos_embed_2d(rows, dtype):
    row = jnp.repeat(jnp.arange(rows), GRID_W)
    col = jnp.tile(jnp.arange(GRID_W), rows)
    quarter = D_MODEL // 4
    freq = 1.0 / (POS_BASE ** (jnp.arange(quarter, dtype=jnp.float32) / quarter))

    def enc(pos):
        ang = pos.astype(jnp.float32)[:, None] * freq[None, :]
        return jnp.concatenate([jnp.sin(ang), jnp.cos(ang)], axis=-1)

    return jnp.concatenate([enc(row), enc(col)], axis=-1).astype(dtype)


def _s5_discretise(lam_re, lam_im, log_dt, b_re, b_im):
    lam_re = lam_re.astype(jnp.float32)
    lam_im = lam_im.astype(jnp.float32)
    dt = jnp.exp(log_dt.astype(jnp.float32))[:, None]
    mag = jnp.exp(lam_re * dt)
    ang = lam_im * dt
    a_re = mag * jnp.cos(ang)
    a_im = mag * jnp.sin(ang)
    den = lam_re * lam_re + lam_im * lam_im
    f_re = ((a_re - 1) * lam_re + a_im * lam_im) / den
    f_im = (a_im * lam_re - (a_re - 1) * lam_im) / den
    b_re = b_re.astype(jnp.float32)
    b_im = b_im.astype(jnp.float32)
    bb_re = f_re[..., None] * b_re - f_im[..., None] * b_im
    bb_im = f_re[..., None] * b_im + f_im[..., None] * b_re
    return a_re, a_im, bb_re, bb_im


def _complex_affine_combine(e1, e2):
    a1r, a1i, b1r, b1i = e1
    a2r, a2i, b2r, b2i = e2
    return (a2r * a1r - a2i * a1i,
            a2r * a1i + a2i * a1r,
            a2r * b1r - a2i * b1i + b2r,
            a2r * b1i + a2i * b1r + b2i)


def _s5_states(u, lam_re, lam_im, log_dt, b_re, b_im, init):
    bsz, length, _ = u.shape
    uf = u.astype(jnp.float32).reshape(bsz, length, S5_GROUPS, S5_GROUP)
    states = []
    for k, rev in enumerate((False, True)):
        a_re, a_im, bb_re, bb_im = _s5_discretise(lam_re[k], lam_im[k], log_dt[k], b_re[k], b_im[k])
        bu_re = jnp.einsum('blgc,gpc->blgp', uf, bb_re)
        bu_im = jnp.einsum('blgc,gpc->blgp', uf, bb_im)
        if init is not None:
            h0_re, h0_im = init[k]
            first = length - 1 if rev else 0
            bu_re = bu_re.at[:, first].add(a_re * h0_re - a_im * h0_im)
            bu_im = bu_im.at[:, first].add(a_re * h0_im + a_im * h0_re)
        elems = (jnp.broadcast_to(a_re, bu_re.shape), jnp.broadcast_to(a_im, bu_im.shape), bu_re, bu_im)
        _, _, h_re, h_im = lax.associative_scan(_complex_affine_combine, elems, reverse=rev, axis=1)
        states.append((h_re, h_im))
    return states


def _s5_final(states):
    (f_re, f_im), (r_re, r_im) = states
    return [(f_re[:, -1], f_im[:, -1]), (r_re[:, 0], r_im[:, 0])]


def _s5_readout(u, states, c_re, c_im, d, w_glu):
    bsz, length, _ = u.shape
    y = d.astype(jnp.float32) * u.astype(jnp.float32)
    for k in range(2):
        h_re, h_im = states[k]
        y_k = (jnp.einsum('blgp,gcp->blgc', h_re, c_re[k].astype(jnp.float32))
               - jnp.einsum('blgp,gcp->blgc', h_im, c_im[k].astype(jnp.float32)))
        y = y + y_k.reshape(bsz, length, W_BRANCH)
    y = jax.nn.gelu(y).astype(u.dtype)
    return y * jax.nn.sigmoid(y @ w_glu)


def _fnet(u, w):
    bsz, length, width = u.shape
    uf = u.astype(jnp.float32).reshape(bsz, length, FNET_GROUPS, width // FNET_GROUPS)
    y = jnp.fft.fft2(uf, axes=(1, 3), norm='ortho').real.reshape(bsz, length, width)
    return y.astype(u.dtype) @ w


def _multiscale_pool(u, w, scale):
    bsz, length, width = u.shape
    cw = width // len(POOL_WINDOWS)
    uf = u.astype(jnp.float32)
    cs = jnp.concatenate([jnp.zeros((bsz, 1, width), jnp.float32), jnp.cumsum(uf, axis=1)], axis=1)
    t = jnp.arange(length)
    outs = []
    for gi, win in enumerate(POOL_WINDOWS):
        lo = jnp.clip(t - win // 2, 0, length)
        hi = jnp.clip(t + win // 2, 0, length)
        csg = cs[..., gi * cw:(gi + 1) * cw]
        s = jnp.take(csg, hi, axis=1) - jnp.take(csg, lo, axis=1)
        cnt = (hi - lo).astype(jnp.float32)[None, :, None]
        outs.append(s / cnt - uf[..., gi * cw:(gi + 1) * cw])
    y = jnp.stack(outs, axis=2)
    y = jnp.einsum('blgc,gcd->blgd', y, w.astype(jnp.float32)).reshape(bsz, length, width)
    return (y * scale.astype(jnp.float32)).astype(u.dtype)


def _conformer_conv(u_val, u_gate, w_dw, b_dw, ln_g, ln_b, w_pw):
    v = u_val * jax.nn.sigmoid(u_gate)
    y = lax.conv_general_dilated(
        v, w_dw.astype(v.dtype)[:, None, :], window_strides=(1,),
        padding=[(CONV_WIDTH // 2, CONV_WIDTH // 2)],
        dimension_numbers=('NWC', 'WIO', 'NWC'), feature_group_count=v.shape[-1]) + b_dw
    y = jax.nn.silu(_layer_norm(y, ln_g, ln_b))
    return y @ w_pw


def _token_mixer(z, s5_states, p):
    bsz, length, _ = z.shape
    wb = W_BRANCH
    y_s5 = _s5_readout(z[..., 0:wb], s5_states, p['s5_c_re'], p['s5_c_im'], p['s5_d'], p['s5_w_glu'])
    y_fn = _fnet(z[..., wb:2 * wb], p['fnet_w'])
    y_pl = _multiscale_pool(z[..., 2 * wb:3 * wb], p['pool_w'], p['pool_scale'])
    y_cv = _conformer_conv(z[..., 3 * wb:4 * wb], z[..., 4 * wb:5 * wb], p['conv_w'], p['conv_b'],
                           p['conv_ln_g'], p['conv_ln_b'], p['conv_w_out'])
    gates = jax.nn.sigmoid(z[..., 5 * wb:].reshape(bsz, length, N_BRANCH, D_MODEL))
    branches = jnp.stack([y_s5, y_fn, y_pl, y_cv], axis=2)
    proj = jnp.einsum('blkc,kcd->blkd', branches, p['w_branch'])
    merged = jnp.einsum('blkd,blkd->bld', gates, proj)
    return merged @ p['w_out']


def _sq_relu_mlp(h, w1, w2):
    a = jax.nn.relu(h @ w1)
    return (a * a) @ w2


def setup_inputs(seed: int = 0) -> dict:
    key = jax.random.key(seed)
    ks = iter(jax.random.split(key, 40))

    def nrm(shape, scale):
        return jax.random.normal(next(ks), shape, jnp.float32) * scale

    n = jnp.arange(S5_STATE, dtype=jnp.float32)
    s5_shape = (DEPTH, 2, S5_GROUPS, S5_STATE)
    return {
        'x': nrm((BATCH, SEQ, D_MODEL), 1.0),
        'c': nrm((BATCH, D_MODEL), 1.0),
        'ctx': nrm((BATCH, CTX_LEN, D_MODEL), 1.0),
        'c_ctx': nrm((D_MODEL,), 1.0),
        'w_mod': nrm((DEPTH, D_MODEL, N_MOD * D_MODEL), D_MODEL ** -0.5),
        'b_mod': nrm((DEPTH, N_MOD * D_MODEL), 0.02),
        'g_norm1': 1.0 + nrm((DEPTH, D_MODEL), 0.02),
        'w_in': nrm((DEPTH, D_MODEL, D_IN), D_MODEL ** -0.5),
        's5_lam_re': -0.5 + nrm(s5_shape, 0.01),
        's5_lam_im': math.pi * n + nrm(s5_shape, 0.01),
        's5_log_dt': jax.random.uniform(next(ks), (DEPTH, 2, S5_GROUPS), jnp.float32,
                                        math.log(1e-3), math.log(1e-1)),
        's5_b_re': nrm((DEPTH, 2, S5_GROUPS, S5_STATE, S5_GROUP), (2 * S5_GROUP) ** -0.5),
        's5_b_im': nrm((DEPTH, 2, S5_GROUPS, S5_STATE, S5_GROUP), (2 * S5_GROUP) ** -0.5),
        's5_c_re': nrm((DEPTH, 2, S5_GROUPS, S5_GROUP, S5_STATE), S5_STATE ** -0.5),
        's5_c_im': nrm((DEPTH, 2, S5_GROUPS, S5_GROUP, S5_STATE), S5_STATE ** -0.5),
        's5_d': nrm((DEPTH, W_BRANCH), 1.0),
        's5_w_glu': nrm((DEPTH, W_BRANCH, W_BRANCH), W_BRANCH ** -0.5),
        'fnet_w': nrm((DEPTH, W_BRANCH, W_BRANCH), W_BRANCH ** -0.5),
        'pool_w': nrm((DEPTH, len(POOL_WINDOWS), W_BRANCH // 4, W_BRANCH // 4), (W_BRANCH // 4) ** -0.5),
        'pool_scale': 1.0 + nrm((DEPTH, W_BRANCH), 0.02),
        'conv_w': nrm((DEPTH, CONV_WIDTH, W_BRANCH), CONV_WIDTH ** -0.5),
        'conv_b': nrm((DEPTH, W_BRANCH), 0.02),
        'conv_ln_g': 1.0 + nrm((DEPTH, W_BRANCH), 0.02),
        'conv_ln_b': nrm((DEPTH, W_BRANCH), 0.02),
        'conv_w_out': nrm((DEPTH, W_BRANCH, W_BRANCH), W_BRANCH ** -0.5),
        'w_branch': nrm((DEPTH, N_BRANCH, W_BRANCH, D_MODEL), W_BRANCH ** -0.5),
        'w_out': nrm((DEPTH, D_MODEL, D_MODEL), D_MODEL ** -0.5),
        'g_norm2': 1.0 + nrm((DEPTH, D_MODEL), 0.02),
        'mlp_w1': nrm((DEPTH, D_MODEL, D_FF), D_MODEL ** -0.5),
        'mlp_w2': nrm((DEPTH, D_FF, D_MODEL), D_FF ** -0.5),
        'g_final': 1.0 + nrm((D_MODEL,), 0.02),
    }


def reference(x, c, ctx, c_ctx, w_mod, b_mod, g_norm1, w_in, s5_lam_re, s5_lam_im, s5_log_dt,
              s5_b_re, s5_b_im, s5_c_re, s5_c_im, s5_d, s5_w_glu, fnet_w, pool_w, pool_scale,
              conv_w, conv_b, conv_ln_g, conv_ln_b, conv_w_out, w_branch, w_out, g_norm2,
              mlp_w1, mlp_w2, g_final):
    rows = x.shape[1] // GRID_W
    x = x + _pos_embed_2d(rows, x.dtype)[None]
    xc = ctx
    c_act = jax.nn.silu(c)
    cc_act = jax.nn.silu(c_ctx)
    for l in range(DEPTH):
        p = {
            's5_c_re': s5_c_re[l], 's5_c_im': s5_c_im[l], 's5_d': s5_d[l], 's5_w_glu': s5_w_glu[l],
            'fnet_w': fnet_w[l], 'pool_w': pool_w[l], 'pool_scale': pool_scale[l],
            'conv_w': conv_w[l], 'conv_b': conv_b[l], 'conv_ln_g': conv_ln_g[l], 'conv_ln_b': conv_ln_b[l],
            'conv_w_out': conv_w_out[l], 'w_branch': w_branch[l], 'w_out': w_out[l],
        }
        s5p = (s5_lam_re[l], s5_lam_im[l], s5_log_dt[l], s5_b_re[l], s5_b_im[l])
        mod = (c_act @ w_mod[l] + b_mod[l])[:, None, :]
        sh1, sc1, ga1, sh2, sc2, ga2 = jnp.split(mod, N_MOD, axis=-1)
        mod_c = cc_act @ w_mod[l] + b_mod[l]
        csh1, csc1, cga1, csh2, csc2, cga2 = jnp.split(mod_c, N_MOD, axis=-1)

        hc = _modulate(xc, g_norm1[l], csh1, csc1)
        if l == DEPTH - 1:
            ctx_states = _s5_states(hc @ w_in[l][:, :W_BRANCH], *s5p, None)
        else:
            zc = hc @ w_in[l]
            ctx_states = _s5_states(zc[..., :W_BRANCH], *s5p, None)
            xc = xc + cga1 * _token_mixer(zc, ctx_states, p)
            xc = xc + cga2 * _sq_relu_mlp(_modulate(xc, g_norm2[l], csh2, csc2), mlp_w1[l], mlp_w2[l])
        ctx_final = _s5_final(ctx_states)

        h = _modulate(x, g_norm1[l], sh1, sc1)
        z = h @ w_in[l]
        lat_states = _s5_states(z[..., :W_BRANCH], *s5p, ctx_final)
        x = x + ga1 * _token_mixer(z, lat_states, p)
        x = x + ga2 * _sq_relu_mlp(_modulate(x, g_norm2[l], sh2, sc2), mlp_w1[l], mlp_w2[l])
    return _rms_norm(x, g_final)
```

```cpp
#include <hip/hip_runtime.h>
#include <hip/hip_cooperative_groups.h>
#include <cstdio>
#include <cstdint>
namespace cg = cooperative_groups;

typedef unsigned short bf16_t;
using bf16x8 = __attribute__((ext_vector_type(8))) short;
using f32x4 = __attribute__((ext_vector_type(4))) float;
using u32x4 = __attribute__((ext_vector_type(4))) unsigned int;
using f32x2 = __attribute__((ext_vector_type(2))) float;

#define NTOK 16896
#define NLAT 16384
#define DM 1024
#define DIN 5376
#define DFF 4096
#define NCHUNK 264
#define LDSS 72
#define SMEM_BYTES 40960

struct Params {
  const float *x, *c, *ctx, *c_ctx, *w_mod, *b_mod, *g1, *w_in, *lam_re, *lam_im, *log_dt, *b_re, *b_im,
      *c_re, *c_im, *s5d, *w_glu, *fnet_w, *pool_w, *pool_scale, *conv_w, *conv_b, *ln_g, *ln_b,
      *conv_w_out, *w_branch, *w_out, *g2, *w1, *w2, *g_final;
  float* out;
  bf16_t *WinT, *WgT, *WbT, *WoT, *W1T, *W2T, *WgluT, *WfnT, *WcvT;
  float* xc;
  bf16_t* hbuf;
  float* modp;
  float* mod;
  float2* Apar;
  float2* Bbar;
  float2* E;
  float2* Hin;
  float2* tw;
  float *zs5, *zfn, *zpl, *zv;
  float2* out1;
  bf16_t *ys, *yfn, *cv, *br, *merged, *hidden;
  bf16_t *zfnP, *ZT, *YT0, *YT1, *H3, *F1m, *Gm;
  unsigned* bar;
};

typedef const __attribute__((address_space(4))) Params CParams;
__device__ __forceinline__ CParams& kparams() {
  CParams* kp = (CParams*)__builtin_amdgcn_kernarg_segment_ptr();
  asm volatile("" : "+s"(kp));
  return *kp;
}

__device__ __forceinline__ bf16_t f2bf(float f) {
  unsigned u = __float_as_uint(f);
  u += 0x7fffu + ((u >> 16) & 1u);
  return (bf16_t)(u >> 16);
}
__device__ __forceinline__ int otid() { int t = threadIdx.x; asm volatile("" : "+v"(t)); return t; }
__device__ __forceinline__ float bf2f(bf16_t b) { return __uint_as_float(((unsigned)b) << 16); }
__device__ __forceinline__ float sigmoidf_(float v) { return 1.f / (1.f + __expf(-v)); }
__device__ __forceinline__ float* xrow(CParams& p, int tok) {
  return tok < NLAT ? p.out + (size_t)tok * DM : p.xc + (size_t)(tok - NLAT) * DM;
}
__device__ __forceinline__ int modvec_of_tok(int tok) { return tok < 8192 ? 0 : (tok < NLAT ? 1 : 2); }
__device__ __forceinline__ void seg_bounds(int tok, int& s0, int& s1) {
  if (tok < 8192) { s0 = 0; s1 = 8192; }
  else if (tok < NLAT) { s0 = 8192; s1 = NLAT; }
  else if (tok < NLAT + 256) { s0 = NLAT; s1 = NLAT + 256; }
  else { s0 = NLAT + 256; s1 = NTOK; }
}
__device__ __forceinline__ float wave_sum(float v) {
#pragma unroll
  for (int o = 32; o > 0; o >>= 1) v += __shfl_xor(v, o);
  return v;
}

#define GROW 40
#define GSTG (256 * GROW)
template <int NI>
__device__ __forceinline__ void gemm_mainloop(const bf16_t* __restrict__ A, int lda,
                                              const bf16_t* __restrict__ B, int ldb, int K,
                                              bf16_t* sbase, bf16_t*  , f32x4 (&acc)[4][NI], const int tid) {
  constexpr int NB = NI / 2;
  const int lane = tid & 63, wid = tid >> 6, wr = wid >> 1, wc = wid & 1;
  const int lrow = tid >> 2, lch = (tid & 3) * 8;
  const int l15 = lane & 15, lq = lane >> 4;
  const bf16_t* pa = A + (size_t)lrow * lda + lch;
  const bf16_t* pb = B + (size_t)lrow * ldb + lch;
  const size_t a64 = (size_t)64 * lda, b64 = (size_t)64 * ldb;
  u32x4 a0[2], a1[2], b0[NB], b1[NB];
  const int nk = K >> 5;
  const int klast = K - 32;
  const int wofs = lrow * GROW + lch;
  const int raofs = (wr * 64 + l15) * GROW + lq * 8;
  const int rbofs = 128 * GROW + (wc * (16 * NI) + l15) * GROW + lq * 8;

#define G_LOAD(ra_, rb_, kofs)                                                                                   \
  {                                                                                                              \
    ra_[0] = *(const u32x4*)(pa + (kofs));                                                                       \
    ra_[1] = *(const u32x4*)(pa + a64 + (kofs));                                                                 \
    _Pragma("unroll") for (int i_ = 0; i_ < NB; i_++) rb_[i_] = *(const u32x4*)(pb + (size_t)i_ * b64 + (kofs)); \
  }
#define G_WRITE(ra_, rb_, st)                                                                                    \
  {                                                                                                              \
    bf16_t* d_ = sbase + (st) * GSTG + wofs;                                                                     \
    *(u32x4*)(d_) = ra_[0];                                                                                      \
    *(u32x4*)(d_ + 64 * GROW) = ra_[1];                                                                          \
    _Pragma("unroll") for (int i_ = 0; i_ < NB; i_++) *(u32x4*)(d_ + (128 + 64 * i_) * GROW) = rb_[i_];          \
  }
#define G_COMPUTE(st)                                                                                            \
  {                                                                                                              \
    const bf16_t* s_ = sbase + (st) * GSTG;                                                                      \
    bf16x8 af[4], bfr[NI];                                                                                       \
    _Pragma("unroll") for (int mi = 0; mi < 4; mi++) af[mi] = *(const bf16x8*)(s_ + raofs + mi * 16 * GROW);     \
    _Pragma("unroll") for (int ni = 0; ni < NI; ni++) bfr[ni] = *(const bf16x8*)(s_ + rbofs + ni * 16 * GROW);   \
    __builtin_amdgcn_s_setprio(1);                                                                               \
    _Pragma("unroll") for (int mi = 0; mi < 4; mi++)                                                             \
    _Pragma("unroll") for (int ni = 0; ni < NI; ni++)                                                            \
      acc[mi][ni] = __builtin_amdgcn_mfma_f32_16x16x32_bf16(af[mi], bfr[ni], acc[mi][ni], 0, 0, 0);              \
    __builtin_amdgcn_s_setprio(0);                                                                               \
  }

  G_LOAD(a0, b0, 0);
  G_LOAD(a1, b1, 32);
  __syncthreads();
  G_WRITE(a0, b0, 0);
  __syncthreads();
  for (int kt = 0; kt < nk; kt += 2) {
    G_LOAD(a0, b0, min((kt + 2) * 32, klast));
    G_COMPUTE(0);
    G_WRITE(a1, b1, 1);
    __syncthreads();
    G_LOAD(a1, b1, min((kt + 3) * 32, klast));
    G_COMPUTE(1);
    G_WRITE(a0, b0, 0);
    __syncthreads();
  }
  asm volatile("s_nop 15\n\ts_nop 15" ::: "memory");
#undef G_LOAD
#undef G_WRITE
#undef G_COMPUTE
}

__device__ __forceinline__ void gemm_mainloop8(const bf16_t* __restrict__ A, int lda,
                                               const bf16_t* __restrict__ B, int ldb, int K,
                                               bf16_t* sbase, f32x4 (&acc)[4][8], const int tid) {
  const int lane = tid & 63, wid = tid >> 6, wr = wid >> 1, wc = wid & 1;
  const int lrow = tid >> 2, lch = (tid & 3) * 8;
  const int l15 = lane & 15, lq = lane >> 4;
  const bf16_t* pa = A + (size_t)lrow * lda + lch;
  const bf16_t* pb = B + (size_t)lrow * ldb + lch;
  const size_t a64 = (size_t)64 * lda, b64 = (size_t)64 * ldb;
  u32x4 ra[2], rb[4];
  const int nk = K >> 5;
  const int wofs = lrow * GROW + lch;
  const int raofs = (wr * 64 + l15) * GROW + lq * 8;
  const int rbofs = 128 * GROW + (wc * 128 + l15) * GROW + lq * 8;
  ra[0] = *(const u32x4*)(pa); ra[1] = *(const u32x4*)(pa + a64);
#pragma unroll
  for (int i = 0; i < 4; i++) rb[i] = *(const u32x4*)(pb + (size_t)i * b64);
  for (int kt = 0; kt < nk; kt++) {
    __syncthreads();
    {
      bf16_t* d_ = sbase + wofs;
      *(u32x4*)(d_) = ra[0];
      *(u32x4*)(d_ + 64 * GROW) = ra[1];
#pragma unroll
      for (int i = 0; i < 4; i++) *(u32x4*)(d_ + (128 + 64 * i) * GROW) = rb[i];
    }
    __syncthreads();
    {
      int kofs = min((kt + 1) * 32, K - 32);
      ra[0] = *(const u32x4*)(pa + kofs); ra[1] = *(const u32x4*)(pa + a64 + kofs);
#pragma unroll
      for (int i = 0; i < 4; i++) rb[i] = *(const u32x4*)(pb + (size_t)i * b64 + kofs);
    }
    bf16x8 af[4], bfr[8];
#pragma unroll
    for (int mi = 0; mi < 4; mi++) af[mi] = *(const bf16x8*)(sbase + raofs + mi * 16 * GROW);
#pragma unroll
    for (int ni = 0; ni < 8; ni++) bfr[ni] = *(const bf16x8*)(sbase + rbofs + ni * 16 * GROW);
    __builtin_amdgcn_s_setprio(1);
#pragma unroll
    for (int mi = 0; mi < 4; mi++)
#pragma unroll
      for (int ni = 0; ni < 8; ni++)
        acc[mi][ni] = __builtin_amdgcn_mfma_f32_16x16x32_bf16(af[mi], bfr[ni], acc[mi][ni], 0, 0, 0);
    __builtin_amdgcn_s_setprio(0);
  }
  asm volatile("s_nop 15\n\ts_nop 15" ::: "memory");
}

template <int NI>
__device__ __forceinline__ void zero_acc(f32x4 (&acc)[4][NI]) {
#pragma unroll
  for (int a = 0; a < 4; a++)
#pragma unroll
    for (int b = 0; b < NI; b++) acc[a][b] = f32x4{0.f, 0.f, 0.f, 0.f};
}

#define EPI_LOOP(BODY)                                                        \
  {                                                                           \
    const int _lane = tid & 63, _wid = tid >> 6;              \
    const int _wr = _wid >> 1, _wc = _wid & 1;                                \
    _Pragma("unroll") for (int mi = 0; mi < 4; mi++)                          \
    _Pragma("unroll") for (int ni = 0; ni < 4; ni++)                          \
    _Pragma("unroll") for (int j = 0; j < 4; j++) {                           \
      const int rl = _wr * 64 + mi * 16 + (_lane >> 4) * 4 + j;               \
      const int cl = _wc * 64 + ni * 16 + (_lane & 15);                       \
      BODY                                                                    \
    }                                                                         \
  }


__device__ __forceinline__ bool swz_tile(int r, int TM, int TN, int SR, int SC, int& tm, int& tn) {
  int b = blockIdx.x;
  int x = b & 7, j = b >> 3;
  int nsc = (TN + SC - 1) / SC, nsr = (TM + SR - 1) / SR;
  int s = r * 8 + x;
  if (s >= nsr * nsc || j >= SR * SC) return false;
  int sr = s / nsc, sc = s - sr * nsc;
  tm = sr * SR + j / SC;
  tn = sc * SC + j % SC;
  return tm < TM && tn < TN;
}
__device__ __forceinline__ int swz_rounds(int TM, int TN, int SR, int SC) {
  int nsc = (TN + SC - 1) / SC, nsr = (TM + SR - 1) / SR;
  return (nsr * nsc + 7) / 8;
}
#define FOR_TILES(TM, TN, SR, SC) for (int r_ = 0, nr_ = swz_rounds(TM, TN, SR, SC); r_ < nr_; r_++) if (int tm = 0, tn = 0; swz_tile(r_, TM, TN, SR, SC, tm, tn))

__device__ __forceinline__ int winperm_src(int n) {
  if (n < 768) return n;
  int r = n - 768;
  int T = r >> 7, rr = r & 127;
  int wc = rr >> 6, a = (rr >> 5) & 1, kind = (rr >> 4) & 1, i = rr & 15;
  int ch = T * 64 + wc * 32 + a * 16 + i;
  return 768 + kind * 256 + ch;
}

__device__ void transpose_tile(const float* __restrict__ src, int ld, int coloff, bool perm, int K,
                               bf16_t* __restrict__ dst, int nt, int kt, float* sm) {
  const int tid = otid();
  const int n0 = nt * 64, k0 = kt * 64;
  {
    int kk = tid >> 2, n16 = (tid & 3) * 16;
    int sc = perm ? winperm_src(n0 + n16) : (n0 + n16);
    const float* sp = src + (size_t)(k0 + kk) * ld + coloff + sc;
    const float* sq = sp + (size_t)64 * ld;
    float4 v0 = *(const float4*)(sp), v1 = *(const float4*)(sp + 4), v2 = *(const float4*)(sp + 8), v3 = *(const float4*)(sp + 12);
    float4 w0 = *(const float4*)(sq), w1 = *(const float4*)(sq + 4), w2 = *(const float4*)(sq + 8), w3 = *(const float4*)(sq + 12);
    __syncthreads();
    float* d = sm + kk * 65 + n16;
    d[0] = v0.x; d[1] = v0.y; d[2] = v0.z; d[3] = v0.w; d[4] = v1.x; d[5] = v1.y; d[6] = v1.z; d[7] = v1.w;
    d[8] = v2.x; d[9] = v2.y; d[10] = v2.z; d[11] = v2.w; d[12] = v3.x; d[13] = v3.y; d[14] = v3.z; d[15] = v3.w;
    float* e = d + 64 * 65;
    e[0] = w0.x; e[1] = w0.y; e[2] = w0.z; e[3] = w0.w; e[4] = w1.x; e[5] = w1.y; e[6] = w1.z; e[7] = w1.w;
    e[8] = w2.x; e[9] = w2.y; e[10] = w2.z; e[11] = w2.w; e[12] = w3.x; e[13] = w3.y; e[14] = w3.z; e[15] = w3.w;
  }
  __syncthreads();
  {
    int nn = tid >> 2, k32 = (tid & 3) * 32;
    unsigned o[16];
#pragma unroll
    for (int j = 0; j < 16; j++)
      o[j] = (unsigned)f2bf(sm[(k32 + 2 * j) * 65 + nn]) | ((unsigned)f2bf(sm[(k32 + 2 * j + 1) * 65 + nn]) << 16);
    u32x4* dp = (u32x4*)(dst + (size_t)(n0 + nn) * K + k0 + k32);
    dp[0] = u32x4{o[0], o[1], o[2], o[3]};
    dp[1] = u32x4{o[4], o[5], o[6], o[7]};
    dp[2] = u32x4{o[8], o[9], o[10], o[11]};
    dp[3] = u32x4{o[12], o[13], o[14], o[15]};
  }
}

#define TR_PER_LAYER 3952
#define N_TR (2 * (TR_PER_LAYER / 2))
#define N_MODP 768
#define N_XINIT 1056
#define N_S5D 16
#define N_TW 32
#define N_DFT 352
#define N_INITA (N_TR + N_MODP + N_XINIT + N_S5D + N_TW + N_DFT)

__device__ void phase_init_a(CParams& p, int item, char* smem) {
  const int tid = otid();
  if (item < N_TR) {
    int l = item / (TR_PER_LAYER / 2), t = (item % (TR_PER_LAYER / 2)) * 2;
    float* sm = (float*)smem;
    if (t < 320) {
      transpose_tile(p.w_in + (size_t)l * DM * DIN, DIN, 0, true, 1024, p.WinT + (size_t)l * 1280 * 1024, t / 16, t % 16, sm);
      return;
    }
    t -= 320;
    if (t < 1024) {
      transpose_tile(p.w_in + (size_t)l * DM * DIN, DIN, 1280, false, 1024, p.WgT + (size_t)l * 4096 * 1024, t / 16, t % 16, sm);
      return;
    }
    t -= 1024;
    if (t < 256) {
      int kb = t / 64, tt = t % 64;
      transpose_tile(p.w_branch + ((size_t)l * 4 + kb) * 256 * 1024, 1024, 0, false, 256,
                     p.WbT + ((size_t)l * 4 + kb) * 1024 * 256, tt / 4, tt % 4, sm);
      return;
    }
    t -= 256;
    if (t < 256) {
      transpose_tile(p.w_out + (size_t)l * DM * DM, DM, 0, false, 1024, p.WoT + (size_t)l * DM * DM, t / 16, t % 16, sm);
      return;
    }
    t -= 256;
    if (t < 1024) {
      transpose_tile(p.w1 + (size_t)l * DM * DFF, DFF, 0, false, 1024, p.W1T + (size_t)l * DFF * DM, t / 16, t % 16, sm);
      return;
    }
    t -= 1024;
    if (t < 1024) {
      transpose_tile(p.w2 + (size_t)l * DFF * DM, DM, 0, false, 4096, p.W2T + (size_t)l * DM * DFF, t / 64, t % 64, sm);
      return;
    }
    t -= 1024;
    {
      int which = t / 16, tt = t % 16;
      const float* src = which == 0 ? p.w_glu : (which == 1 ? p.fnet_w : p.conv_w_out);
      bf16_t* dst = which == 0 ? p.WgluT : (which == 1 ? p.WfnT : p.WcvT);
      transpose_tile(src + (size_t)l * 65536, 256, 0, false, 256, dst + (size_t)l * 65536, tt / 4, tt % 4, sm);
      return;
    }
  }
  item -= N_TR;
  if (item < N_MODP) {
    int l = item / 384, r = item % 384, nc = r / 16, kc = r % 16;
    float* sv = (float*)smem;
    __syncthreads();
    if (tid < 192) {
      int v = tid / 64, k = kc * 64 + (tid & 63);
      float cvv = v < 2 ? p.c[v * DM + k] : p.c_ctx[k];
      sv[tid] = cvv * sigmoidf_(cvv);
    }
    __syncthreads();
    int n = nc * 256 + tid;
    const float* w = p.w_mod + ((size_t)l * DM + kc * 64) * 6144 + n;
    float a0 = 0.f, a1 = 0.f, a2 = 0.f;
#pragma unroll 8
    for (int k = 0; k < 64; k++) {
      float wv = w[(size_t)k * 6144];
      a0 += sv[k] * wv; a1 += sv[64 + k] * wv; a2 += sv[128 + k] * wv;
    }
    float* dst = p.modp + ((size_t)(kc * 2 + l) * 3) * 6144 + n;
    dst[0] = a0; dst[6144] = a1; dst[2 * 6144] = a2;
    return;
  }
  item -= N_MODP;
  if (item < N_XINIT) {
    int d = tid * 4;
    int quarter = d >> 8;
    float fr[4];
#pragma unroll
    for (int e = 0; e < 4; e++) fr[e] = 1.0f / powf(10000.f, (float)((d + e) & 255) / 256.f);
    for (int i = 0; i < 16; i++) {
      int tok = item * 16 + i;
      if (tok < NLAT) {
        float4 xv = *(const float4*)(p.x + (size_t)tok * DM + d);
        int t = tok & 8191;
        float pos = (quarter < 2) ? (float)(t >> 6) : (float)(t & 63);
        float pe[4];
#pragma unroll
        for (int e = 0; e < 4; e++) {
          float ang = pos * fr[e];
          pe[e] = (quarter & 1) ? cosf(ang) : sinf(ang);
        }
        xv.x += pe[0]; xv.y += pe[1]; xv.z += pe[2]; xv.w += pe[3];
        *(float4*)(p.out + (size_t)tok * DM + d) = xv;
      } else {
        float4 xv = *(const float4*)(p.ctx + (size_t)(tok - NLAT) * DM + d);
        *(float4*)(p.xc + (size_t)(tok - NLAT) * DM + d) = xv;
      }
    }
    return;
  }
  item -= N_XINIT;
  if (item < N_S5D) {
    int idx = item * 256 + tid;
    float lre = p.lam_re[idx], lim = p.lam_im[idx];
    float dt = expf(p.log_dt[idx >> 6]);
    float mag = expf(lre * dt), ang = lim * dt;
    float are = mag * cosf(ang), aim = mag * sinf(ang);
    float den = lre * lre + lim * lim;
    float fre = ((are - 1.f) * lre + aim * lim) / den;
    float fim = (aim * lre - (are - 1.f) * lim) / den;
    p.Apar[idx] = make_float2(are, aim);
    for (int cc = 0; cc < 16; cc++) {
      float bre = p.b_re[(size_t)idx * 16 + cc], bim = p.b_im[(size_t)idx * 16 + cc];
      p.Bbar[(size_t)idx * 16 + cc] = make_float2(fre * bre - fim * bim, fre * bim + fim * bre);
    }
    return;
  }
  item -= N_S5D;
  if (item < N_TW) {
    int j = item * 256 + tid;
    float s, c;
    sincospif((float)j * (2.0f / 8192.0f), &s, &c);
    p.tw[j] = make_float2(c, -s);
    return;
  }
  item -= N_TW;
  {
    int e = item * 256 + tid;
    float sn, cs;
    if (e < 8192) {
      int n = e >> 6, c = e & 63;
      int wc = n >> 6, q = (n >> 4) & 3, i = n & 15;
      int a = q >> 1, ri = q & 1;
      int m = wc * 32 + a * 16 + i;
      sincospif((float)((m * c) & 63) * (2.0f / 64.0f), &sn, &cs);
      p.H3[e] = f2bf(ri == 0 ? cs : -sn);
    } else if (e < 8192 + 65536) {
      int ee = e - 8192;
      int row = ee >> 8, col = ee & 255;
      int k1 = row >> 1, ro = row & 1, t1 = col >> 1, ri = col & 1;
      sincospif((float)((k1 * t1) & 127) * (2.0f / 128.0f), &sn, &cs);
      float v = (ro == ri) ? cs : (ro == 0 ? sn : -sn);
      p.F1m[ee] = f2bf(v);
    } else {
      int ee = e - 8192 - 65536;
      int row = ee >> 7, col = ee & 127;
      float v = 0.f;
      if (row < 64) {
        int t2 = col >> 1, ri = col & 1;
        sincospif((float)((row * t2) & 63) * (2.0f / 64.0f), &sn, &cs);
        v = (ri == 0 ? cs : sn) * 0.001381067932f;
      }
      p.Gm[ee] = f2bf(v);
    }
  }
}

__device__ void phase_init_b(CParams& p, int item) {
  int o = item * 256 + otid();
  int n = o % 6144, l = o / (3 * 6144);
  float a = p.b_mod[l * 6144 + n];
  for (int kc = 0; kc < 16; kc++) a += p.modp[(size_t)kc * 2 * 3 * 6144 + o];
  p.mod[o] = a;
}

__device__ void phase_modulate(CParams& p, int l, int which, int item) {
  const int tid = otid();
  const int lane = tid & 63, wid = tid >> 6;
  int tok = item * 4 + wid;
  const float* xr = xrow(p, tok);
  const float* g = (which == 0 ? p.g1 : p.g2) + l * DM;
  const float* md = p.mod + ((size_t)l * 3 + modvec_of_tok(tok)) * 6144 + (which == 0 ? 0 : 3072);
  float4 v[4];
  float ss = 0.f;
  const bool pend = (tok >= NLAT) && ((l == 0 && which == 1) || (l == 1 && which == 0));
#pragma unroll
  for (int i = 0; i < 4; i++) {
    v[i] = *(const float4*)(xr + i * 256 + lane * 4);
    if (pend) {
      const float* pp = (const float*)p.YT1 + (size_t)(tok - NLAT) * DM + i * 256 + lane * 4;
#pragma unroll
      for (int k4 = 0; k4 < 4; k4++) {
        float4 q = *(const float4*)(pp + (size_t)k4 * 512 * DM);
        v[i].x += q.x; v[i].y += q.y; v[i].z += q.z; v[i].w += q.w;
      }
      *(float4*)(p.xc + (size_t)(tok - NLAT) * DM + i * 256 + lane * 4) = v[i];
    }
    ss += v[i].x * v[i].x + v[i].y * v[i].y + v[i].z * v[i].z + v[i].w * v[i].w;
  }
  ss = wave_sum(ss);
  float rstd = rsqrtf(ss * (1.f / DM) + 1e-6f);
#pragma unroll
  for (int i = 0; i < 4; i++) {
    int d = i * 256 + lane * 4;
    float4 gg = *(const float4*)(g + d);
    float4 sh = *(const float4*)(md + d);
    float4 sc = *(const float4*)(md + 1024 + d);
    float h0 = v[i].x * rstd * gg.x * (1.f + sc.x) + sh.x;
    float h1 = v[i].y * rstd * gg.y * (1.f + sc.y) + sh.y;
    float h2 = v[i].z * rstd * gg.z * (1.f + sc.z) + sh.z;
    float h3 = v[i].w * rstd * gg.w * (1.f + sc.w) + sh.w;
    uint2 o;
    o.x = (unsigned)f2bf(h0) | ((unsigned)f2bf(h1) << 16);
    o.y = (unsigned)f2bf(h2) | ((unsigned)f2bf(h3) << 16);
    *(uint2*)(p.hbuf + (size_t)tok * DM + d) = o;
  }
}

__device__ void phase_inproj(CParams& p, int l, int tm, int tn, char* smem) {
  const int tid = otid();
  bf16_t* sA = (bf16_t*)smem;
  bf16_t* sB = sA + 128 * LDSS;
  const bool lat = tm < 128;
  const int tbase = lat ? ((tm >> 6) * 8192 + (tm & 63)) : tm * 128;
  const int tstr = lat ? 64 : 1;
  f32x4 acc[4][4];
  zero_acc<4>(acc);
  gemm_mainloop<4>(p.hbuf + (size_t)tbase * DM, DM * tstr, p.WinT + ((size_t)l * 1280 + tn * 128) * 1024, 1024, 1024, sA, sB, acc, tid);
  if (tn < 6) {
    int cb = (tn & 1) * 128;
    if (lat && (tn == 2 || tn == 3)) {
      EPI_LOOP({ p.zfnP[(size_t)(tm * 128 + rl) * 256 + cb + cl] = f2bf(acc[mi][ni][j]); })
    } else {
      float* dst = tn < 2 ? p.zs5 : (tn < 4 ? p.zfn : p.zpl);
      EPI_LOOP({ dst[(size_t)(tbase + rl * tstr) * 256 + cb + cl] = acc[mi][ni][j]; })
    }
  } else {
    int T = tn - 6;
    const int lane = tid & 63, wid = tid >> 6, wr = wid >> 1, wc = wid & 1;
#pragma unroll
    for (int mi = 0; mi < 4; mi++)
#pragma unroll
      for (int a = 0; a < 2; a++)
#pragma unroll
        for (int j = 0; j < 4; j++) {
          int rl = wr * 64 + mi * 16 + (lane >> 4) * 4 + j;
          int ch = T * 64 + wc * 32 + a * 16 + (lane & 15);
          float val = acc[mi][2 * a][j], gt = acc[mi][2 * a + 1][j];
          p.zv[(size_t)(tbase + rl * tstr) * 256 + ch] = val * sigmoidf_(gt);
        }
  }
}

__device__ void phase_fn_step1(CParams& p, int item, char* smem) {
  const int tid = otid();
  bf16_t* sA = (bf16_t*)smem;
  bf16_t* sB = sA + 128 * LDSS;
  int tile = item >> 2, grp = item & 3;
  f32x4 acc[4][4];
  zero_acc<4>(acc);
  gemm_mainloop<4>(p.zfnP + (size_t)tile * 128 * 256 + grp * 64, 256, p.H3, 64, 64, sA, sB, acc, tid);
  const int lane = tid & 63, wid = tid >> 6, wr = wid >> 1, wc = wid & 1, l15 = lane & 15, lq = lane >> 4;
#pragma unroll
  for (int mi = 0; mi < 4; mi++)
#pragma unroll
    for (int a = 0; a < 2; a++) {
      int t1 = wr * 64 + mi * 16 + lq * 4;
      int ch = grp * 64 + wc * 32 + a * 16 + l15;
      u32x4 o;
      o[0] = (unsigned)f2bf(acc[mi][2 * a][0]) | ((unsigned)f2bf(acc[mi][2 * a + 1][0]) << 16);
      o[1] = (unsigned)f2bf(acc[mi][2 * a][1]) | ((unsigned)f2bf(acc[mi][2 * a + 1][1]) << 16);
      o[2] = (unsigned)f2bf(acc[mi][2 * a][2]) | ((unsigned)f2bf(acc[mi][2 * a + 1][2]) << 16);
      o[3] = (unsigned)f2bf(acc[mi][2 * a][3]) | ((unsigned)f2bf(acc[mi][2 * a + 1][3]) << 16);
      *(u32x4*)(p.ZT + ((size_t)tile * 256 + ch) * 256 + t1 * 2) = o;
    }
}
__device__ void phase_fn_step2(CParams& p, int item, char* smem) {
  const int tid = otid();
  bf16_t* sA = (bf16_t*)smem;
  bf16_t* sB = sA + 128 * LDSS;
  int tile = item >> 2, mt = (item >> 1) & 1, nt = item & 1;
  int seg = tile >> 6, t2 = tile & 63;
  f32x4 acc[4][4];
  zero_acc<4>(acc);
  gemm_mainloop<4>(p.F1m + (size_t)mt * 128 * 256, 256, p.ZT + ((size_t)tile * 256 + nt * 128) * 256, 256, 256, sA, sB, acc, tid);
  const int lane = tid & 63, wid = tid >> 6, wr = wid >> 1, wc = wid & 1, l15 = lane & 15, lq = lane >> 4;
  const float2* __restrict__ tw = p.tw;
#pragma unroll
  for (int mi = 0; mi < 4; mi++)
#pragma unroll
    for (int h = 0; h < 2; h++) {
      int k1 = mt * 64 + ((wr * 64 + mi * 16 + lq * 4) >> 1) + h;
      float2 w = tw[(t2 * k1) & 8191];
#pragma unroll
      for (int ni = 0; ni < 4; ni++) {
        float re = acc[mi][ni][2 * h], im = acc[mi][ni][2 * h + 1];
        float orr = re * w.x - im * w.y, oi = re * w.y + im * w.x;
        int ch = nt * 128 + wc * 64 + ni * 16 + l15;
        unsigned o = (unsigned)f2bf(orr) | ((unsigned)f2bf(oi) << 16);
        *(unsigned*)((seg ? p.YT1 : p.YT0) + (((size_t)t2 * 128 + k1) * 256 + ch) * 2) = o;
      }
    }
}
__device__ void phase_fn_step3(CParams& p, int item, char* smem) {
  const int tid = otid();
  bf16_t* sA = (bf16_t*)smem;
  bf16_t* sB = sA + 128 * LDSS;
  int sk = item >> 1, nt = item & 1;
  int seg = sk >> 7, k1 = sk & 127;
  const int lane = tid & 63, wid = tid >> 6, wr = wid >> 1, wc = wid & 1, l15 = lane & 15, lq = lane >> 4;
  f32x4 acc[4][4];
  zero_acc<4>(acc);
  const int lr = tid >> 3, lk = (tid & 7) * 8;
#pragma unroll 1
  for (int ks = 0; ks < 2; ks++) {
    u32x4 ra[4], rb[4];
#pragma unroll
    for (int i = 0; i < 4; i++) ra[i] = *(const u32x4*)(p.Gm + (size_t)(lr + i * 32) * 128 + ks * 64 + lk);
#pragma unroll
    for (int i = 0; i < 4; i++) {
      int idx = tid + i * 256;
      int t2l = idx >> 5, chq = (idx & 31) * 4;
      int t2 = ks * 32 + t2l;
      rb[i] = *(const u32x4*)((seg ? p.YT1 : p.YT0) + (((size_t)t2 * 128 + k1) * 256 + nt * 128 + chq) * 2);
    }
    __syncthreads();
#pragma unroll
    for (int i = 0; i < 4; i++) *(u32x4*)(sA + (lr + i * 32) * LDSS + lk) = ra[i];
#pragma unroll
    for (int i = 0; i < 4; i++) {
      int idx = tid + i * 256;
      int t2l = idx >> 5, chq = (idx & 31) * 4;
#pragma unroll
      for (int e = 0; e < 4; e++) *(unsigned*)(sB + (chq + e) * LDSS + t2l * 2) = rb[i][e];
    }
    __syncthreads();
#pragma unroll
    for (int k2s = 0; k2s < 2; k2s++) {
      bf16x8 af[4], bfr[4];
#pragma unroll
      for (int mi = 0; mi < 4; mi++) af[mi] = *(const bf16x8*)(sA + (wr * 64 + mi * 16 + l15) * LDSS + k2s * 32 + lq * 8);
#pragma unroll
      for (int ni = 0; ni < 4; ni++) bfr[ni] = *(const bf16x8*)(sB + (wc * 64 + ni * 16 + l15) * LDSS + k2s * 32 + lq * 8);
#pragma unroll
      for (int mi = 0; mi < 4; mi++)
#pragma unroll
        for (int ni = 0; ni < 4; ni++)
          acc[mi][ni] = __builtin_amdgcn_mfma_f32_16x16x32_bf16(af[mi], bfr[ni], acc[mi][ni], 0, 0, 0);
    }
  }
  asm volatile("s_nop 15\n\ts_nop 15" ::: "memory");
  if (wr == 0) {
#pragma unroll
    for (int mi = 0; mi < 4; mi++)
#pragma unroll
      for (int ni = 0; ni < 4; ni++)
#pragma unroll
        for (int j = 0; j < 4; j++) {
          int k2 = mi * 16 + lq * 4 + j;
          int ch = nt * 128 + wc * 64 + ni * 16 + l15;
          p.yfn[(size_t)(seg * 8192 + k1 + 128 * k2) * 256 + ch] = f2bf(acc[mi][ni][j]);
        }
  }
}

__device__ void phase_s5_pass1(CParams& p, int l, int item, char* smem) {
  const int tid = otid(), lane = tid & 63, wid = tid >> 6;
  int q = item >> 3, dir = (item >> 2) & 1, gq = item & 3;
  int g = gq * 4 + wid;
  float* us = (float*)smem + wid * 1024;
  int tok0 = q * 64;
  __syncthreads();
  {
    const float* src = p.zs5 + (size_t)(tok0 + lane) * 256 + g * 16;
#pragma unroll
    for (int i = 0; i < 4; i++) *(float4*)(us + lane * 16 + i * 4) = *(const float4*)(src + i * 4);
  }
  int pidx = ((l * 2 + dir) * 16 + g) * 64 + lane;
  float2 A = p.Apar[pidx];
  f32x2 bb[16];
#pragma unroll
  for (int cc = 0; cc < 16; cc++) {
    float2 b = p.Bbar[(size_t)pidx * 16 + cc];
    bb[cc] = f32x2{b.x, b.y};
  }
  __syncthreads();
  float hr = 0.f, hi = 0.f;
  for (int i = 0; i < 64; i++) {
    int t = dir == 0 ? i : 63 - i;
    float u[16];
#pragma unroll
    for (int k = 0; k < 4; k++) {
      float4 uv = *(const float4*)(us + t * 16 + k * 4);
      u[k * 4] = uv.x; u[k * 4 + 1] = uv.y; u[k * 4 + 2] = uv.z; u[k * 4 + 3] = uv.w;
    }
    f32x2 bu = {0.f, 0.f};
#pragma unroll
    for (int cc = 0; cc < 16; cc++) bu = __builtin_elementwise_fma(bb[cc], f32x2{u[cc], u[cc]}, bu);
    float nr = A.x * hr - A.y * hi + bu[0];
    float ni = A.x * hi + A.y * hr + bu[1];
    hr = nr; hi = ni;
  }
  p.E[(((size_t)q * 2 + dir) * 16 + g) * 64 + lane] = make_float2(hr, hi);
}

__device__ void phase_s5_carry(CParams& p, int l, int item) {
  int idx = item * 256 + otid();
  int b = idx >> 11, dir = (idx >> 10) & 1, gp = idx & 1023;
  float2 A = p.Apar[(l * 2 + dir) * 1024 + gp];
  float ar = A.x, ai = A.y;
#pragma unroll
  for (int s = 0; s < 6; s++) { float nr = ar * ar - ai * ai, ni = 2.f * ar * ai; ar = nr; ai = ni; }
  float hr = 0.f, hi = 0.f;
#pragma unroll 4
  for (int s = 0; s < 132; s++) {
    int q;
    if (dir == 0) q = s < 4 ? (256 + 4 * b + s) : (128 * b + (s - 4));
    else q = s < 4 ? (256 + 4 * b + 3 - s) : (128 * b + 127 - (s - 4));
    size_t o = ((size_t)q * 2 + dir) * 1024 + gp;
    float2 e = p.E[o];
    p.Hin[o] = make_float2(hr, hi);
    float nr = ar * hr - ai * hi + e.x;
    float ni = ar * hi + ai * hr + e.y;
    hr = nr; hi = ni;
  }
}

__device__ void phase_s5_pass2(CParams& p, int l, int item, char* smem) {
  const int tid = otid(), lane = tid & 63, wid = tid >> 6;
  int q = item >> 2, gq = item & 3;
  int g = gq * 4 + wid;
  float* us = (float*)smem + wid * 1024;
  bf16_t* hs = (bf16_t*)(smem + 16384) + wid * (16 * 136);
  int tok0 = q * 64;
  __syncthreads();
  {
    const float* src = p.zs5 + (size_t)(tok0 + lane) * 256 + g * 16;
#pragma unroll
    for (int i = 0; i < 4; i++) *(float4*)(us + lane * 16 + i * 4) = *(const float4*)(src + i * 4);
  }
  __syncthreads();
  f32x4 acc[4];
#pragma unroll
  for (int s = 0; s < 4; s++) acc[s] = f32x4{0.f, 0.f, 0.f, 0.f};
  const int l15 = lane & 15, lq = lane >> 4;
#pragma unroll
  for (int dir = 0; dir < 2; dir++) {
    int pidx = ((l * 2 + dir) * 16 + g) * 64 + lane;
    float2 A = p.Apar[pidx];
    f32x2 bb[16];
#pragma unroll
    for (int cc = 0; cc < 16; cc++) {
      float2 b = p.Bbar[(size_t)pidx * 16 + cc];
      bb[cc] = f32x2{b.x, b.y};
    }
    bf16x8 cf[4];
#pragma unroll
    for (int ks = 0; ks < 4; ks++) {
      int k = ks * 32 + lq * 8;
      bool im = k >= 64;
      const float* src = (im ? p.c_im : p.c_re) + ((((size_t)(l * 2 + dir) * 16 + g) * 16 + l15) * 64) + (k & 63);
      float4 v0 = *(const float4*)src, v1 = *(const float4*)(src + 4);
      float sgn = im ? -1.f : 1.f;
      cf[ks][0] = (short)f2bf(sgn * v0.x); cf[ks][1] = (short)f2bf(sgn * v0.y);
      cf[ks][2] = (short)f2bf(sgn * v0.z); cf[ks][3] = (short)f2bf(sgn * v0.w);
      cf[ks][4] = (short)f2bf(sgn * v1.x); cf[ks][5] = (short)f2bf(sgn * v1.y);
      cf[ks][6] = (short)f2bf(sgn * v1.z); cf[ks][7] = (short)f2bf(sgn * v1.w);
    }
    float2 h0 = p.Hin[(((size_t)q * 2 + dir) * 16 + g) * 64 + lane];
    float hr = h0.x, hi = h0.y;
#pragma unroll
    for (int s = 0; s < 4; s++) {
      const int sb = dir == 0 ? s : 3 - s;
      for (int i = 0; i < 16; i++) {
        int tl = dir == 0 ? i : 15 - i;
        int t = sb * 16 + tl;
        float u[16];
#pragma unroll
        for (int k = 0; k < 4; k++) {
          float4 uv = *(const float4*)(us + t * 16 + k * 4);
          u[k * 4] = uv.x; u[k * 4 + 1] = uv.y; u[k * 4 + 2] = uv.z; u[k * 4 + 3] = uv.w;
        }
        f32x2 bu = {0.f, 0.f};
#pragma unroll
        for (int cc = 0; cc < 16; cc++) bu = __builtin_elementwise_fma(bb[cc], f32x2{u[cc], u[cc]}, bu);
        float nr = A.x * hr - A.y * hi + bu[0];
        float ni = A.x * hi + A.y * hr + bu[1];
        hr = nr; hi = ni;
        hs[tl * 136 + lane] = f2bf(hr);
        hs[tl * 136 + 64 + lane] = f2bf(hi);
      }
      __syncthreads();
#pragma unroll
      for (int ks = 0; ks < 4; ks++) {
        bf16x8 a = *(const bf16x8*)(hs + l15 * 136 + ks * 32 + lq * 8);
        acc[sb] = __builtin_amdgcn_mfma_f32_16x16x32_bf16(a, cf[ks], acc[sb], 0, 0, 0);
      }
      __syncthreads();
    }
  }
  asm volatile("s_nop 15\n\ts_nop 15" ::: "memory");
  float dd = p.s5d[l * 256 + g * 16 + l15];
#pragma unroll
  for (int sb = 0; sb < 4; sb++)
#pragma unroll
    for (int j = 0; j < 4; j++) {
      int t = sb * 16 + lq * 4 + j;
      float y = acc[sb][j] + dd * us[t * 16 + l15];
      float z = 0.7978845608028654f * (y + 0.044715f * y * y * y);
      float ge = y / (1.f + __expf(-2.f * z));
      p.ys[(size_t)(tok0 + t) * 256 + g * 16 + l15] = f2bf(ge);
    }
}

__device__ void phase_fnet1(CParams& p, int item) {
  const int ch = otid();
  int segbase, N1, m1, m2, t2, k1b;
  if (item < 1024) {
    int seg = item >> 9; t2 = (item >> 3) & 63; k1b = (item & 7) * 16;
    segbase = seg * 8192; N1 = 128; m1 = 64; m2 = 1;
  } else {
    int it = item - 1024;
    int seg = it >> 6; t2 = it & 63; k1b = 0;
    segbase = NLAT + seg * 256; N1 = 4; m1 = 2048; m2 = 32;
  }
  float are[16], aim[16];
#pragma unroll
  for (int k = 0; k < 16; k++) { are[k] = 0.f; aim[k] = 0.f; }
  const float* src = p.zfn + (size_t)(segbase + t2) * 256 + ch;
  const float2* __restrict__ tw = p.tw;
  for (int t1 = 0; t1 < N1; t1++) {
    float u = src[(size_t)t1 * 64 * 256];
#pragma unroll
    for (int k = 0; k < 16; k++) {
      float2 w = tw[((k1b + k) * t1 * m1) & 8191];
      are[k] += u * w.x; aim[k] += u * w.y;
    }
  }
#pragma unroll
  for (int k = 0; k < 16; k++) {
    int k1 = k1b + k;
    if (k1 < N1) {
      float2 w = tw[(t2 * k1 * m2) & 8191];
      float re = are[k] * w.x - aim[k] * w.y;
      float im = are[k] * w.y + aim[k] * w.x;
      p.out1[(size_t)(segbase + k1 * 64 + t2) * 256 + ch] = make_float2(re, im);
    }
  }
}

__device__ void phase_fnet2(CParams& p, int item, char* smem) {
  const int tid = otid();
  int segbase, N1, k1, k2b;
  float scale;
  if (item < 1024) {
    int seg = item >> 9; k1 = (item >> 2) & 127; k2b = (item & 3) * 16;
    segbase = seg * 8192; N1 = 128; scale = 0.001381067932f;
  } else {
    int it = item - 1024;
    int seg = it >> 4; k1 = (it >> 2) & 3; k2b = (it & 3) * 16;
    segbase = NLAT + seg * 256; N1 = 4; scale = 0.0078125f;
  }
  float2* sbuf = (float2*)smem;
  float2* tw64 = (float2*)(smem + 32768);
  const float2* __restrict__ tw = p.tw;
  float are[16], aim[16];
#pragma unroll
  for (int k = 0; k < 16; k++) { are[k] = 0.f; aim[k] = 0.f; }
  const float2* src = p.out1 + (size_t)(segbase + k1 * 64) * 256 + tid;
  for (int t2 = 0; t2 < 64; t2++) {
    float2 v = src[(size_t)t2 * 256];
#pragma unroll
    for (int k = 0; k < 16; k++) {
      float2 w = tw[((k2b + k) * t2 * 128) & 8191];
      are[k] += v.x * w.x - v.y * w.y;
      aim[k] += v.x * w.y + v.y * w.x;
    }
  }
  __syncthreads();
#pragma unroll
  for (int k = 0; k < 16; k++) sbuf[k * 256 + tid] = make_float2(are[k], aim[k]);
  if (tid < 64) tw64[tid] = tw[tid * 128];
  __syncthreads();
  int grp = tid >> 6, m = tid & 63;
  float o[16];
#pragma unroll
  for (int k = 0; k < 16; k++) o[k] = 0.f;
  for (int cc = 0; cc < 64; cc++) {
    float2 w = tw64[(m * cc) & 63];
#pragma unroll
    for (int k = 0; k < 16; k++) {
      float2 v = sbuf[k * 256 + grp * 64 + cc];
      o[k] += v.x * w.x - v.y * w.y;
    }
  }
#pragma unroll
  for (int k = 0; k < 16; k++) {
    int tok = segbase + k1 + N1 * (k2b + k);
    p.yfn[(size_t)tok * 256 + tid] = f2bf(o[k] * scale);
  }
}

__device__ void phase_conv(CParams& p, int l, int item, char* smem) {
  const int tid = otid(), lane = tid & 63, wid = tid >> 6;
  int t0 = item * 16;
  int s0, s1;
  seg_bounds(t0, s0, s1);
  float* yb = (float*)smem;
  float w[31];
#pragma unroll
  for (int j = 0; j < 31; j++) w[j] = p.conv_w[((size_t)l * 31 + j) * 256 + tid];
  float acc[16];
  float bias = p.conv_b[l * 256 + tid];
#pragma unroll
  for (int i = 0; i < 16; i++) acc[i] = bias;
#pragma unroll
  for (int m = 0; m < 46; m++) {
    int tok = t0 - 15 + m;
    float v = (tok >= s0 && tok < s1) ? p.zv[(size_t)tok * 256 + tid] : 0.f;
#pragma unroll
    for (int i = 0; i < 16; i++) {
      if (m - i >= 0 && m - i <= 30) acc[i] += w[m - i] * v;
    }
  }
  __syncthreads();
#pragma unroll
  for (int i = 0; i < 16; i++) yb[i * 256 + tid] = acc[i];
  __syncthreads();
  float4 gg = *(const float4*)(p.ln_g + l * 256 + lane * 4);
  float4 bb = *(const float4*)(p.ln_b + l * 256 + lane * 4);
#pragma unroll
  for (int r = 0; r < 4; r++) {
    int i = wid * 4 + r;
    float4 v = *(const float4*)(yb + i * 256 + lane * 4);
    float mu = wave_sum(v.x + v.y + v.z + v.w) * (1.f / 256.f);
    float d0 = v.x - mu, d1 = v.y - mu, d2 = v.z - mu, d3 = v.w - mu;
    float var = wave_sum(d0 * d0 + d1 * d1 + d2 * d2 + d3 * d3) * (1.f / 256.f);
    float rs = rsqrtf(var + 1e-6f);
    float y0 = d0 * rs * gg.x + bb.x, y1 = d1 * rs * gg.y + bb.y, y2 = d2 * rs * gg.z + bb.z, y3 = d3 * rs * gg.w + bb.w;
    y0 *= sigmoidf_(y0); y1 *= sigmoidf_(y1); y2 *= sigmoidf_(y2); y3 *= sigmoidf_(y3);
    uint2 o;
    o.x = (unsigned)f2bf(y0) | ((unsigned)f2bf(y1) << 16);
    o.y = (unsigned)f2bf(y2) | ((unsigned)f2bf(y3) << 16);
    *(uint2*)(p.cv + (size_t)(t0 + i) * 256 + lane * 4) = o;
  }
}

__device__ void phase_pool(CParams& p, int l, int item, char* smem) {
  const int tid = otid();
  int t0 = item * 16;
  int s0, s1;
  seg_bounds(t0, s0, s1);
  float* pl = (float*)smem;
  int grp = tid >> 6, d = tid & 63;
  int half = 1 << grp;
  const float* zp = p.zpl + tid;
  __syncthreads();
  {
    float s = 0.f;
    for (int w = 0; w < 2 * half; w++) {
      int tt = t0 - half + w;
      s += (tt >= s0 && tt < s1) ? zp[(size_t)tt * 256] : 0.f;
    }
#pragma unroll
    for (int i = 0; i < 16; i++) {
      int t = t0 + i;
      int lo = max(t - half, s0), hi = min(t + half, s1);
      pl[i * 256 + tid] = s / (float)(hi - lo) - zp[(size_t)t * 256];
      int ta = t + half, tr = t - half;
      float va = (ta < s1) ? zp[(size_t)ta * 256] : 0.f;
      float vr = (tr >= s0) ? zp[(size_t)tr * 256] : 0.f;
      s += va - vr;
    }
  }
  __syncthreads();
  float acc[16];
#pragma unroll
  for (int i = 0; i < 16; i++) acc[i] = 0.f;
  const float* wp = p.pool_w + ((size_t)(l * 4 + grp) * 64) * 64 + d;
  for (int cc = 0; cc < 64; cc += 4) {
    float w0 = wp[cc * 64], w1 = wp[(cc + 1) * 64], w2 = wp[(cc + 2) * 64], w3 = wp[(cc + 3) * 64];
#pragma unroll
    for (int i = 0; i < 16; i++) {
      float4 pv = *(const float4*)(pl + i * 256 + grp * 64 + cc);
      acc[i] += pv.x * w0 + pv.y * w1 + pv.z * w2 + pv.w * w3;
    }
  }
  float sc = p.pool_scale[l * 256 + tid];
#pragma unroll
  for (int i = 0; i < 16; i++) p.br[(size_t)(t0 + i) * 1024 + 512 + tid] = f2bf(acc[i] * sc);
}

__device__ void phase_small(CParams& p, int l, int item, char* smem) {
  const int tid = otid();
  bf16_t* sA = (bf16_t*)smem;
  bf16_t* sB = sA + 128 * LDSS;
  int which = item / 264, r = item % 264, tm = r >> 1, tn = r & 1;
  int row0 = tm * 128, col0 = tn * 128;
  const bf16_t* A = which == 0 ? p.ys : (which == 1 ? p.yfn : p.cv);
  const bf16_t* B = (which == 0 ? p.WgluT : (which == 1 ? p.WfnT : p.WcvT)) + (size_t)l * 65536;
  f32x4 acc[4][4];
  zero_acc<4>(acc);
  gemm_mainloop<4>(A + (size_t)row0 * 256, 256, B + (size_t)col0 * 256, 256, 256, sA, sB, acc, tid);
  if (which == 0) {
    EPI_LOOP({
      float y = bf2f(p.ys[(size_t)(row0 + rl) * 256 + col0 + cl]);
      p.br[(size_t)(row0 + rl) * 1024 + col0 + cl] = f2bf(y * sigmoidf_(acc[mi][ni][j]));
    })
  } else {
    int cb = which == 1 ? 256 : 768;
    EPI_LOOP({ p.br[(size_t)(row0 + rl) * 1024 + cb + col0 + cl] = f2bf(acc[mi][ni][j]); })
  }
}

template <int NI>
__device__ void phase_merge(CParams& p, int l, int tm, int tn, char* smem) {
  const int tid = otid();
  bf16_t* sA = (bf16_t*)smem;
  bf16_t* sB = sA + 128 * LDSS;
  int row0 = tm * 128, col0 = tn * (32 * NI);
  f32x4 mer[4][NI];
  zero_acc<NI>(mer);
#pragma unroll 1
  for (int kb0 = 0; kb0 < 4; kb0++) {
    int kb = kb0;
    asm volatile("" : "+s"(kb));
    int tid2 = tid;
    asm volatile("" : "+v"(tid2));
    unsigned pk[4][NI][2];
    {
      f32x4 acc[4][NI];
      zero_acc<NI>(acc);
      gemm_mainloop<NI>(p.br + (size_t)row0 * 1024 + kb * 256, 1024,
                        p.WbT + (((size_t)l * 4 + kb) * 1024 + col0) * 256, 256, 256, sA, sB, acc, tid2);
#pragma unroll
      for (int mi = 0; mi < 4; mi++)
#pragma unroll
        for (int ni = 0; ni < NI; ni++) {
          pk[mi][ni][0] = (unsigned)f2bf(acc[mi][ni][0]) | ((unsigned)f2bf(acc[mi][ni][1]) << 16);
          pk[mi][ni][1] = (unsigned)f2bf(acc[mi][ni][2]) | ((unsigned)f2bf(acc[mi][ni][3]) << 16);
        }
    }
    f32x4 acc[4][NI];
    zero_acc<NI>(acc);
    asm volatile("" : "+v"(tid2));
    gemm_mainloop<NI>(p.hbuf + (size_t)row0 * DM, DM,
                      p.WgT + (((size_t)l * 4 + kb) * 1024 + col0) * 1024, 1024, 1024, sA, sB, acc, tid2);
#pragma unroll
    for (int mi = 0; mi < 4; mi++)
#pragma unroll
      for (int ni = 0; ni < NI; ni++) {
        unsigned p0 = pk[mi][ni][0], p1 = pk[mi][ni][1];
        mer[mi][ni][0] += sigmoidf_(acc[mi][ni][0]) * __uint_as_float(p0 << 16);
        mer[mi][ni][1] += sigmoidf_(acc[mi][ni][1]) * __uint_as_float(p0 & 0xffff0000u);
        mer[mi][ni][2] += sigmoidf_(acc[mi][ni][2]) * __uint_as_float(p1 << 16);
        mer[mi][ni][3] += sigmoidf_(acc[mi][ni][3]) * __uint_as_float(p1 & 0xffff0000u);
      }
  }
  {
    const int lane = tid & 63, wid = tid >> 6, wr = wid >> 1, wc = wid & 1;
#pragma unroll
    for (int mi = 0; mi < 4; mi++)
#pragma unroll
      for (int ni = 0; ni < NI; ni++)
#pragma unroll
        for (int j = 0; j < 4; j++) {
          int rl = wr * 64 + mi * 16 + (lane >> 4) * 4 + j;
          int cl = wc * (16 * NI) + ni * 16 + (lane & 15);
          p.merged[(size_t)(row0 + rl) * 1024 + col0 + cl] = f2bf(mer[mi][ni][j]);
        }
  }
}

__device__ void phase_merge4(CParams& p, int l, int tm, int tn, char* smem) {
  const int tid = otid();
  bf16_t* sA = (bf16_t*)smem;
  bf16_t* sB = sA + 128 * LDSS;
  int row0 = tm * 128, col0 = tn * 128;
  unsigned mer[4][4][2];
#pragma unroll
  for (int mi = 0; mi < 4; mi++)
#pragma unroll
    for (int ni = 0; ni < 4; ni++) { mer[mi][ni][0] = 0u; mer[mi][ni][1] = 0u; }
#pragma unroll 1
  for (int kb0 = 0; kb0 < 4; kb0++) {
    int kb = kb0;
    asm volatile("" : "+s"(kb));
    int tid2 = tid;
    asm volatile("" : "+v"(tid2));
    unsigned pk[4][4][2];
    {
      f32x4 acc[4][4];
      zero_acc<4>(acc);
      gemm_mainloop<4>(p.br + (size_t)row0 * 1024 + kb * 256, 1024,
                       p.WbT + (((size_t)l * 4 + kb) * 1024 + col0) * 256, 256, 256, sA, sB, acc, tid2);
#pragma unroll
      for (int mi = 0; mi < 4; mi++)
#pragma unroll
        for (int ni = 0; ni < 4; ni++) {
          pk[mi][ni][0] = (unsigned)f2bf(acc[mi][ni][0]) | ((unsigned)f2bf(acc[mi][ni][1]) << 16);
          pk[mi][ni][1] = (unsigned)f2bf(acc[mi][ni][2]) | ((unsigned)f2bf(acc[mi][ni][3]) << 16);
        }
    }
    f32x4 acc[4][4];
    zero_acc<4>(acc);
    asm volatile("" : "+v"(tid2));
    gemm_mainloop<4>(p.hbuf + (size_t)row0 * DM, DM,
                     p.WgT + (((size_t)l * 4 + kb) * 1024 + col0) * 1024, 1024, 1024, sA, sB, acc, tid2);
#pragma unroll
    for (int mi = 0; mi < 4; mi++)
#pragma unroll
      for (int ni = 0; ni < 4; ni++) {
        unsigned p0 = pk[mi][ni][0], p1 = pk[mi][ni][1], m0 = mer[mi][ni][0], m1 = mer[mi][ni][1];
        float r0 = __uint_as_float(m0 << 16) + sigmoidf_(acc[mi][ni][0]) * __uint_as_float(p0 << 16);
        float r1 = __uint_as_float(m0 & 0xffff0000u) + sigmoidf_(acc[mi][ni][1]) * __uint_as_float(p0 & 0xffff0000u);
        float r2 = __uint_as_float(m1 << 16) + sigmoidf_(acc[mi][ni][2]) * __uint_as_float(p1 << 16);
        float r3 = __uint_as_float(m1 & 0xffff0000u) + sigmoidf_(acc[mi][ni][3]) * __uint_as_float(p1 & 0xffff0000u);
        mer[mi][ni][0] = (unsigned)f2bf(r0) | ((unsigned)f2bf(r1) << 16);
        mer[mi][ni][1] = (unsigned)f2bf(r2) | ((unsigned)f2bf(r3) << 16);
      }
  }
  {
    const int lane = tid & 63, wid = tid >> 6, wr = wid >> 1, wc = wid & 1;
#pragma unroll
    for (int mi = 0; mi < 4; mi++)
#pragma unroll
      for (int ni = 0; ni < 4; ni++)
#pragma unroll
        for (int j = 0; j < 4; j++) {
          int rl = wr * 64 + mi * 16 + (lane >> 4) * 4 + j;
          int cl = wc * 64 + ni * 16 + (lane & 15);
          unsigned w = mer[mi][ni][j >> 1];
          p.merged[(size_t)(row0 + rl) * 1024 + col0 + cl] = (bf16_t)((j & 1) ? (w >> 16) : (w & 0xffffu));
        }
  }
}

__device__ void phase_proj_res(CParams& p, int l, int tm, int tn, char* smem, const bf16_t* A, int K,
                               const bf16_t* Bt, int gate_off, float gscale) {
  const int tid = otid();
  bf16_t* sA = (bf16_t*)smem;
  bf16_t* sB = sA + 128 * LDSS;
  int row0 = tm * 128, col0 = tn * 128;
  f32x4 acc[4][4];
  zero_acc<4>(acc);
  gemm_mainloop<4>(A + (size_t)row0 * K, K, Bt + (size_t)col0 * K, K, K, sA, sB, acc, tid);
  const float* md = p.mod + ((size_t)l * 3 + modvec_of_tok(row0)) * 6144 + gate_off;
  EPI_LOOP({
    float* xp = xrow(p, row0 + rl) + col0 + cl;
    *xp = *xp + gscale * md[col0 + cl] * acc[mi][ni][j];
  })
}

__device__ void phase_proj_res_ctx(CParams& p, int l, int item, char* smem, const bf16_t* A, int K,
                                   const bf16_t* Bt, int gate_off) {
  const int tid = otid();
  bf16_t* sA = (bf16_t*)smem;
  bf16_t* sB = sA + 128 * LDSS;
  int ks = item & 3, tn = (item >> 2) & 7, tmc = item >> 5;
  int row0 = NLAT + tmc * 128, col0 = tn * 128;
  int kc = K >> 2;
  f32x4 acc[4][4];
  zero_acc<4>(acc);
  gemm_mainloop<4>(A + (size_t)row0 * K + ks * kc, K, Bt + (size_t)col0 * K + ks * kc, K, kc, sA, sB, acc, tid);
  const float* md = p.mod + ((size_t)l * 3 + 2) * 6144 + gate_off;
  float* part = (float*)p.YT1 + (size_t)ks * 512 * DM;
  EPI_LOOP({ part[(size_t)(row0 - NLAT + rl) * DM + col0 + cl] = md[col0 + cl] * acc[mi][ni][j]; })
}

__device__ void phase_mlp1_big(CParams& p, int l, int tm, int tn, char* smem) {
  const int tid = otid();
  int row0 = tm * 128, col0 = tn * 256;
  f32x4 acc[4][8];
  zero_acc<8>(acc);
  gemm_mainloop8(p.hbuf + (size_t)row0 * DM, DM, p.W1T + ((size_t)l * DFF + col0) * DM, DM, DM, (bf16_t*)smem, acc, tid);
  const int lane = tid & 63, wid = tid >> 6, wr = wid >> 1, wc = wid & 1;
#pragma unroll
  for (int mi = 0; mi < 4; mi++)
#pragma unroll
    for (int ni = 0; ni < 8; ni++)
#pragma unroll
      for (int j = 0; j < 4; j++) {
        int rl = wr * 64 + mi * 16 + (lane >> 4) * 4 + j;
        int cl = wc * 128 + ni * 16 + (lane & 15);
        float a = fmaxf(acc[mi][ni][j], 0.f);
        p.hidden[(size_t)(row0 + rl) * DFF + col0 + cl] = f2bf(a * a);
      }
}

__device__ void phase_mlp1(CParams& p, int l, int tm, int tn, char* smem) {
  const int tid = otid();
  bf16_t* sA = (bf16_t*)smem;
  bf16_t* sB = sA + 128 * LDSS;
  int row0 = tm * 128, col0 = tn * 128;
  f32x4 acc[4][4];
  zero_acc<4>(acc);
  gemm_mainloop<4>(p.hbuf + (size_t)row0 * DM, DM, p.W1T + ((size_t)l * DFF + col0) * DM, DM, DM, sA, sB, acc, tid);
  EPI_LOOP({
    float a = fmaxf(acc[mi][ni][j], 0.f);
    p.hidden[(size_t)(row0 + rl) * DFF + col0 + cl] = f2bf(a * a);
  })
}

__device__ void phase_final(CParams& p, int item) {
  const int tid = otid();
  const int lane = tid & 63, wid = tid >> 6;
  int tok = item * 4 + wid;
  float* xr = p.out + (size_t)tok * DM;
  float4 v[4];
  float ss = 0.f;
#pragma unroll
  for (int i = 0; i < 4; i++) {
    v[i] = *(const float4*)(xr + i * 256 + lane * 4);
    ss += v[i].x * v[i].x + v[i].y * v[i].y + v[i].z * v[i].z + v[i].w * v[i].w;
  }
  ss = wave_sum(ss);
  float rstd = rsqrtf(ss * (1.f / DM) + 1e-6f);
#pragma unroll
  for (int i = 0; i < 4; i++) {
    int d = i * 256 + lane * 4;
    float4 gg = *(const float4*)(p.g_final + d);
    float4 o;
    o.x = v[i].x * rstd * gg.x; o.y = v[i].y * rstd * gg.y; o.z = v[i].z * rstd * gg.z; o.w = v[i].w * rstd * gg.w;
    *(float4*)(xr + d) = o;
  }
}


#define XB_TMO      128
#define XB_XCNT(j)  (256  + 64 * (j))
#define XB_XSUB(j)  (1280 + 64 * (j))
#define XB_XGEN(j)  (2304 + 64 * (j))
#define XB_TOP      3328
#define XB_TOPGEN   3392
#define XCD_BAR_WORDS 3456
#define XB_SPIN_CAP (1u << 20)
#define LAS __attribute__((address_space(3)))
__device__ __forceinline__ unsigned xb_ld(unsigned* p)              { return __hip_atomic_load(p, __ATOMIC_RELAXED, __HIP_MEMORY_SCOPE_AGENT); }
__device__ __forceinline__ unsigned xb_add(unsigned* p, unsigned v) { return __hip_atomic_fetch_add(p, v, __ATOMIC_RELAXED, __HIP_MEMORY_SCOPE_AGENT); }
__device__ __forceinline__ unsigned xb_xcc_id() { return (unsigned)__builtin_amdgcn_s_getreg((3 << 11) | 20) & 0xFu; }
#define XB_SPIN(cond, bar) do { unsigned _sp = 0; while (cond) { __builtin_amdgcn_s_sleep(1); \
    if ((++_sp & 255u) == 0u) { if (xb_ld(&(bar)[XB_TMO])) break; if (_sp > XB_SPIN_CAP) { atomicAdd(&(bar)[XB_TMO], 1u); break; } } } } while (0)
struct XcdBarrier { unsigned* bar; unsigned x; volatile LAS unsigned* st; };
__device__ __forceinline__ XcdBarrier xcd_barrier_post(unsigned* bar, volatile LAS unsigned* st) {
  XcdBarrier b; b.bar = bar; b.x = xb_xcc_id(); b.st = st;
  if (threadIdx.x == 0) (void)xb_add(&bar[XB_XCNT(b.x)], 1u);
  return b;
}
__device__ __forceinline__ void xcd_barrier_complete(unsigned* bar, unsigned x, unsigned& nloc, unsigned& nx) {
  const unsigned G = gridDim.x * gridDim.y * gridDim.z;
  unsigned sum, cnt, mine, sp = 0u;
  for (;;) {
    sum = 0u; cnt = 0u; mine = 0u;
#pragma unroll
    for (unsigned j = 0; j < 16; ++j) { const unsigned c = xb_ld(&bar[XB_XCNT(j)]); sum += c; cnt += (c > 0u) ? 1u : 0u; mine = (j == x) ? c : mine; }
    if (sum == G) break;
    __builtin_amdgcn_s_sleep(1);
    if ((++sp & 255u) == 0u) { if (xb_ld(&bar[XB_TMO])) break; if (sp > XB_SPIN_CAP) { atomicAdd(&bar[XB_TMO], 1u); break; } }
  }
  nloc = mine > 0u ? mine : 1u; nx = cnt > 0u ? cnt : 1u;
}
__device__ __forceinline__ void xcd_barrier(const XcdBarrier& b) {
  asm volatile("s_waitcnt vmcnt(0)" ::: "memory");
  __syncthreads();
  if (threadIdx.x == 0) {
    unsigned* bar = b.bar;
    __builtin_amdgcn_s_waitcnt(0);
    unsigned nloc = b.st[0], nx = b.st[1];
    if (nloc == 0u) { xcd_barrier_complete(bar, b.x, nloc, nx); b.st[0] = nloc; b.st[1] = nx; }
    const unsigned old = xb_add(&bar[XB_XSUB(b.x)], 1u);
    const unsigned gen = old / nloc;
    if (old + 1u == (gen + 1u) * nloc) {
      __builtin_amdgcn_fence(__ATOMIC_RELEASE, "agent");
      asm volatile("s_waitcnt vmcnt(0)" ::: "memory");
      const unsigned og = xb_add(&bar[XB_TOP], 1u);
      const unsigned tg = og / nx;
      if (og + 1u == (tg + 1u) * nx) xb_add(&bar[XB_TOPGEN], 1u);
      else XB_SPIN(xb_ld(&bar[XB_TOPGEN]) == tg, bar);
      __builtin_amdgcn_fence(__ATOMIC_ACQUIRE, "agent");
      xb_add(&bar[XB_XGEN(b.x)], 1u);
      asm volatile("s_waitcnt vmcnt(0)" ::: "memory");
    } else {
      XB_SPIN(xb_ld(&bar[XB_XGEN(b.x)]) == gen, bar);
      __builtin_amdgcn_fence(__ATOMIC_ACQUIRE, "agent");
      asm volatile("s_waitcnt vmcnt(0)" ::: "memory");
    }
  }
  __syncthreads();
}

#define FOR_ITEMS(N) for (int item = blockIdx.x; item < (N); item += gridDim.x)

#ifndef PROBE_DUP
#define PROBE_DUP 0
#endif
#define REPS(k) for (int rep = 0; rep < ((PROBE_DUP == (k)) ? 2 : 1); rep++)

__global__ void __launch_bounds__(256, 2) fwd_megakernel(Params p_unused) {
  cg::grid_group grid = cg::this_grid();
  __shared__ __attribute__((aligned(16))) char smem[SMEM_BYTES];
  __shared__ uint4 xb_words;
  if (threadIdx.x == 0) xb_words = make_uint4(0u, 0u, 0u, 0u);
  __syncthreads();
  XcdBarrier xb = xcd_barrier_post(kparams().bar, (volatile LAS unsigned*)&xb_words);

  REPS(5) {
    { CParams& p = kparams(); FOR_ITEMS(N_INITA) phase_init_a(p, item, smem); }
    grid.sync();
    { CParams& p = kparams(); FOR_ITEMS(144) phase_init_b(p, item); }
    xcd_barrier(xb);
  }

#pragma unroll 1
  for (int l0 = 0; l0 < 2; l0++) {
    int l = l0;
    asm volatile("" : "+s"(l));
    REPS(6) {
      { CParams& p = kparams(); FOR_ITEMS(4224) phase_modulate(p, l, 0, item); }
      xcd_barrier(xb);
    }
    REPS(1) {
      { CParams& p = kparams(); FOR_TILES(132, 10, 6, 10) phase_inproj(p, l, tm, tn, smem); }
      xcd_barrier(xb);
    }
    REPS(2) {
      { CParams& p = kparams();
        FOR_ITEMS(512 + 128 + 2112) {
          if (item < 512) phase_fn_step1(p, item, smem);
          else if (item < 640) phase_fnet1(p, item - 512 + 1024);
          else phase_s5_pass1(p, l, item - 640, smem);
        }
      }
      xcd_barrier(xb);
    }
    REPS(3) {
      { CParams& p = kparams();
        FOR_ITEMS(16 + 32 + 1056) {
          if (item < 16) phase_s5_carry(p, l, item);
          else if (item < 48) phase_fnet2(p, item - 16 + 1024, smem);
          else phase_conv(p, l, item - 48, smem);
        }
      }
      xcd_barrier(xb);
      { CParams& p = kparams(); FOR_ITEMS(512) phase_fn_step2(p, item, smem); }
      xcd_barrier(xb);
    }
    REPS(4) {
      { CParams& p = kparams();
        FOR_ITEMS(2112 + 512) {
          if (item < 1056) phase_s5_pass2(p, l, item, smem);
          else if (item < 2112) phase_pool(p, l, item - 1056, smem);
          else phase_fn_step3(p, item - 2112, smem);
        }
      }
      xcd_barrier(xb);
      { CParams& p = kparams(); FOR_ITEMS(792) phase_small(p, l, item, smem); }
      xcd_barrier(xb);
    }
    REPS(8) {
      { CParams& p = kparams();
        FOR_TILES(128, 8, 8, 8) phase_merge4(p, l, tm, tn, smem);
        if (l == 0) { FOR_ITEMS(64) phase_merge<2>(p, l, 128 + (item >> 4), item & 15, smem); } }
      xcd_barrier(xb);
    }
    REPS(1) {
      { CParams& p = kparams();
        FOR_TILES(128, 8, 8, 8) phase_proj_res(p, l, tm, tn, smem, p.merged, 1024, p.WoT + (size_t)l * DM * DM, 2048, rep == 0 ? 1.f : 0.f);
        if (l == 0 && rep == 0) { FOR_ITEMS(128) phase_proj_res_ctx(p, l, item, smem, p.merged, 1024, p.WoT + (size_t)l * DM * DM, 2048); } }
      xcd_barrier(xb);
    }
    REPS(6) {
      { CParams& p = kparams(); FOR_ITEMS(4224) phase_modulate(p, l, 1, item); }
      xcd_barrier(xb);
    }
    REPS(9) {
      { CParams& p = kparams();
        FOR_TILES(128, 16, 4, 16) phase_mlp1_big(p, l, tm, tn, smem);
        if (l == 0) { FOR_ITEMS(128) phase_mlp1(p, l, 128 + (item >> 5), item & 31, smem); } }
      xcd_barrier(xb);
    }
    REPS(1) {
      { CParams& p = kparams();
        FOR_TILES(128, 8, 8, 8) phase_proj_res(p, l, tm, tn, smem, p.hidden, 4096, p.W2T + (size_t)l * DM * DFF, 5120, rep == 0 ? 1.f : 0.f);
        if (l == 0 && rep == 0) { FOR_ITEMS(128) phase_proj_res_ctx(p, l, item, smem, p.hidden, 4096, p.W2T + (size_t)l * DM * DFF, 5120); } }
      xcd_barrier(xb);
    }
  }
  if (PROBE_DUP == 7) { for (int i = 0; i < 10; i++) xcd_barrier(xb); }
  { CParams& p = kparams(); FOR_ITEMS(4096) phase_final(p, item); }
}

extern "C" void kernel_launch(void* const* d_in, const int* in_sizes, int n_in, void* d_out, int out_size,
                              void* d_ws, size_t ws_size, hipStream_t stream) {
  Params p{};
  const float** fp = (const float**)&p;
  for (int i = 0; i < 31; i++) fp[i] = (const float*)d_in[i];
  p.out = (float*)d_out;
  char* w = (char*)d_ws;
  size_t off = 0;
  auto take = [&](size_t bytes) { char* r = w + off; off += (bytes + 255) & ~(size_t)255; return r; };
  p.WinT = (bf16_t*)take((size_t)2 * 1280 * 1024 * 2);
  p.WgT = (bf16_t*)take((size_t)2 * 4096 * 1024 * 2);
  p.WbT = (bf16_t*)take((size_t)2 * 4 * 1024 * 256 * 2);
  p.WoT = (bf16_t*)take((size_t)2 * 1024 * 1024 * 2);
  p.W1T = (bf16_t*)take((size_t)2 * 4096 * 1024 * 2);
  p.W2T = (bf16_t*)take((size_t)2 * 4096 * 1024 * 2);
  p.WgluT = (bf16_t*)take((size_t)2 * 65536 * 2);
  p.WfnT = (bf16_t*)take((size_t)2 * 65536 * 2);
  p.WcvT = (bf16_t*)take((size_t)2 * 65536 * 2);
  p.xc = (float*)take((size_t)512 * 1024 * 4);
  p.hbuf = (bf16_t*)take((size_t)NTOK * 1024 * 2);
  p.modp = (float*)take((size_t)16 * 2 * 3 * 6144 * 4);
  p.mod = (float*)take((size_t)2 * 3 * 6144 * 4);
  p.Apar = (float2*)take((size_t)4096 * 8);
  p.Bbar = (float2*)take((size_t)4096 * 16 * 8);
  p.E = (float2*)take((size_t)NCHUNK * 2 * 1024 * 8);
  p.Hin = (float2*)take((size_t)NCHUNK * 2 * 1024 * 8);
  p.tw = (float2*)take((size_t)8192 * 8);
  p.H3 = (bf16_t*)take((size_t)8192 * 2);
  p.F1m = (bf16_t*)take((size_t)65536 * 2);
  p.Gm = (bf16_t*)take((size_t)16384 * 2);
  char* R = take((size_t)NTOK * 4096 * 2);
  p.hidden = (bf16_t*)R;
  size_t zsz = (size_t)NTOK * 256 * 4;
  p.zs5 = (float*)R;
  p.zfn = (float*)(R + zsz);
  p.zpl = (float*)(R + 2 * zsz);
  p.zv = (float*)(R + 3 * zsz);
  p.merged = (bf16_t*)R;
  p.out1 = (float2*)(R + 4 * zsz);
  p.ZT = (bf16_t*)(R + 4 * zsz);

  p.zfnP = (bf16_t*)(R + zsz);
  p.br = (bf16_t*)(R + 4 * zsz);
  size_t ysz = (size_t)NTOK * 256 * 2;
  p.ys = (bf16_t*)(R + 6 * zsz);
  p.yfn = (bf16_t*)(R + 6 * zsz + ysz);
  p.cv = (bf16_t*)(R + 6 * zsz + 2 * ysz);
  p.YT0 = (bf16_t*)(R + 6 * zsz + 3 * ysz);
  p.YT1 = (bf16_t*)take((size_t)64 * 128 * 256 * 2 * 2);
  p.bar = (unsigned*)take((size_t)XCD_BAR_WORDS * 4);
  if (off > ws_size) { fprintf(stderr, "workspace too small: need %zu have %zu\n", off, ws_size); return; }

  static int grid_blocks = 0;
  if (!grid_blocks) {
    int dev = 0, cus = 0, per_cu = 0;
    hipGetDevice(&dev);
    hipDeviceGetAttribute(&cus, hipDeviceAttributeMultiprocessorCount, dev);
    hipOccupancyMaxActiveBlocksPerMultiprocessor(&per_cu, fwd_megakernel, 256, 0);
    if (per_cu > 2) per_cu = 2;
    grid_blocks = cus * per_cu;
  }
  hipMemsetAsync(p.bar, 0, (size_t)XCD_BAR_WORDS * 4, stream);
  void* args[] = {&p};
  hipError_t e = hipLaunchCooperativeKernel((void*)fwd_megakernel, dim3(grid_blocks), dim3(256), args, 0, stream);
  if (e != hipSuccess) fprintf(stderr, "cooperative launch failed: %s (grid %d)\n", hipGetErrorString(e), grid_blocks);
}
```

```cpp
#include <hip/hip_runtime.h>
#include <hip/hip_cooperative_groups.h>
#include <cstdio>
#include <cstdint>
namespace cg = cooperative_groups;

typedef unsigned short bf16_t;
using bf16x8 = __attribute__((ext_vector_type(8))) short;
using f32x4 = __attribute__((ext_vector_type(4))) float;
using u32x4 = __attribute__((ext_vector_type(4))) unsigned int;
using f32x2 = __attribute__((ext_vector_type(2))) float;

#define NTOK 16896
#define NLAT 16384
#define DM 1024
#define DIN 5376
#define DFF 4096
#define NCHUNK 264
#define LDSS 72
#define SMEM_BYTES 40960

struct Params {
  const float *x, *c, *ctx, *c_ctx, *w_mod, *b_mod, *g1, *w_in, *lam_re, *lam_im, *log_dt, *b_re, *b_im,
      *c_re, *c_im, *s5d, *w_glu, *fnet_w, *pool_w, *pool_scale, *conv_w, *conv_b, *ln_g, *ln_b,
      *conv_w_out, *w_branch, *w_out, *g2, *w1, *w2, *g_final;
  float* out;
  bf16_t *WinT, *WgT, *WbT, *WoT, *W1T, *W2T, *WgluT, *WfnT, *WcvT;
  float* xc;
  bf16_t* hbuf;
  float* modp;
  float* mod;
  float2* Apar;
  float2* Bbar;
  float2* E;
  float2* Hin;
  float2* tw;
  float *zs5, *zfn, *zpl, *zv;
  float2* out1;
  bf16_t *ys, *yfn, *cv, *br, *merged, *hidden;
  bf16_t *zfnP, *ZT, *YT0, *YT1, *H3, *F1m, *Gm;
  unsigned* bar;
};

typedef const __attribute__((address_space(4))) Params CParams;
__device__ __forceinline__ CParams& kparams() {
  CParams* kp = (CParams*)__builtin_amdgcn_kernarg_segment_ptr();
  asm volatile("" : "+s"(kp));
  return *kp;
}

__device__ __forceinline__ bf16_t f2bf(float f) {
  unsigned u = __float_as_uint(f);
  u += 0x7fffu + ((u >> 16) & 1u);
  return (bf16_t)(u >> 16);
}
__device__ __forceinline__ int otid() { int t = threadIdx.x; asm volatile("" : "+v"(t)); return t; }
__device__ __forceinline__ float bf2f(bf16_t b) { return __uint_as_float(((unsigned)b) << 16); }
__device__ __forceinline__ float sigmoidf_(float v) { return 1.f / (1.f + __expf(-v)); }
__device__ __forceinline__ float* xrow(CParams& p, int tok) {
  return tok < NLAT ? p.out + (size_t)tok * DM : p.xc + (size_t)(tok - NLAT) * DM;
}
__device__ __forceinline__ int modvec_of_tok(int tok) { return tok < 8192 ? 0 : (tok < NLAT ? 1 : 2); }
__device__ __forceinline__ void seg_bounds(int tok, int& s0, int& s1) {
  if (tok < 8192) { s0 = 0; s1 = 8192; }
  else if (tok < NLAT) { s0 = 8192; s1 = NLAT; }
  else if (tok < NLAT + 256) { s0 = NLAT; s1 = NLAT + 256; }
  else { s0 = NLAT + 256; s1 = NTOK; }
}
__device__ __forceinline__ float wave_sum(float v) {
#pragma unroll
  for (int o = 32; o > 0; o >>= 1) v += __shfl_xor(v, o);
  return v;
}

#define GROW 40
#define GSTG (256 * GROW)
template <int NI>
__device__ __forceinline__ void gemm_mainloop(const bf16_t* __restrict__ A, int lda,
                                              const bf16_t* __restrict__ B, int ldb, int K,
                                              bf16_t* sbase, bf16_t*  , f32x4 (&acc)[4][NI], const int tid) {
  constexpr int NB = NI / 2;
  const int lane = tid & 63, wid = tid >> 6, wr = wid >> 1, wc = wid & 1;
  const int lrow = tid >> 2, lch = (tid & 3) * 8;
  const int l15 = lane & 15, lq = lane >> 4;
  const bf16_t* pa = A + (size_t)lrow * lda + lch;
  const bf16_t* pb = B + (size_t)lrow * ldb + lch;
  const size_t a64 = (size_t)64 * lda, b64 = (size_t)64 * ldb;
  u32x4 a0[2], a1[2], b0[NB], b1[NB];
  const int nk = K >> 5;
  const int klast = K - 32;
  const int wofs = lrow * GROW + lch;
  const int raofs = (wr * 64 + l15) * GROW + lq * 8;
  const int rbofs = 128 * GROW + (wc * (16 * NI) + l15) * GROW + lq * 8;

#define G_LOAD(ra_, rb_, kofs)                                                                                   \
  {                                                                                                              \
    ra_[0] = *(const u32x4*)(pa + (kofs));                                                                       \
    ra_[1] = *(const u32x4*)(pa + a64 + (kofs));                                                                 \
    _Pragma("unroll") for (int i_ = 0; i_ < NB; i_++) rb_[i_] = *(const u32x4*)(pb + (size_t)i_ * b64 + (kofs)); \
  }
#define G_WRITE(ra_, rb_, st)                                                                                    \
  {                                                                                                              \
    bf16_t* d_ = sbase + (st) * GSTG + wofs;                                                                     \
    *(u32x4*)(d_) = ra_[0];                                                                                      \
    *(u32x4*)(d_ + 64 * GROW) = ra_[1];                                                                          \
    _Pragma("unroll") for (int i_ = 0; i_ < NB; i_++) *(u32x4*)(d_ + (128 + 64 * i_) * GROW) = rb_[i_];          \
  }
#define G_COMPUTE(st)                                                                                            \
  {                                                                                                              \
    const bf16_t* s_ = sbase + (st) * GSTG;                                                                      \
    bf16x8 af[4], bfr[NI];                                                                                       \
    _Pragma("unroll") for (int mi = 0; mi < 4; mi++) af[mi] = *(const bf16x8*)(s_ + raofs + mi * 16 * GROW);     \
    _Pragma("unroll") for (int ni = 0; ni < NI; ni++) bfr[ni] = *(const bf16x8*)(s_ + rbofs + ni * 16 * GROW);   \
    _Pragma("unroll") for (int mi = 0; mi < 4; mi++)                                                             \
    _Pragma("unroll") for (int ni = 0; ni < NI; ni++)                                                            \
      acc[mi][ni] = __builtin_amdgcn_mfma_f32_16x16x32_bf16(af[mi], bfr[ni], acc[mi][ni], 0, 0, 0);              \
  }

  G_LOAD(a0, b0, 0);
  G_LOAD(a1, b1, 32);
  __syncthreads();
  G_WRITE(a0, b0, 0);
  __syncthreads();
  for (int kt = 0; kt < nk; kt += 2) {
    G_LOAD(a0, b0, min((kt + 2) * 32, klast));
    G_COMPUTE(0);
    G_WRITE(a1, b1, 1);
    __syncthreads();
    G_LOAD(a1, b1, min((kt + 3) * 32, klast));
    G_COMPUTE(1);
    G_WRITE(a0, b0, 0);
    __syncthreads();
  }
  asm volatile("s_nop 15\n\ts_nop 15" ::: "memory");
#undef G_LOAD
#undef G_WRITE
#undef G_COMPUTE
}

__device__ __forceinline__ void gemm_mainloop8(const bf16_t* __restrict__ A, int lda,
                                               const bf16_t* __restrict__ B, int ldb, int K,
                                               bf16_t* sbase, f32x4 (&acc)[4][8], const int tid) {
  const int lane = tid & 63, wid = tid >> 6, wr = wid >> 1, wc = wid & 1;
  const int lrow = tid >> 2, lch = (tid & 3) * 8;
  const int l15 = lane & 15, lq = lane >> 4;
  const bf16_t* pa = A + (size_t)lrow * lda + lch;
  const bf16_t* pb = B + (size_t)lrow * ldb + lch;
  const size_t a64 = (size_t)64 * lda, b64 = (size_t)64 * ldb;
  u32x4 ra[2], rb[4];
  const int nk = K >> 5;
  const int wofs = lrow * GROW + lch;
  const int raofs = (wr * 64 + l15) * GROW + lq * 8;
  const int rbofs = 128 * GROW + (wc * 128 + l15) * GROW + lq * 8;
  ra[0] = *(const u32x4*)(pa); ra[1] = *(const u32x4*)(pa + a64);
#pragma unroll
  for (int i = 0; i < 4; i++) rb[i] = *(const u32x4*)(pb + (size_t)i * b64);
  for (int kt = 0; kt < nk; kt++) {
    __syncthreads();
    {
      bf16_t* d_ = sbase + wofs;
      *(u32x4*)(d_) = ra[0];
      *(u32x4*)(d_ + 64 * GROW) = ra[1];
#pragma unroll
      for (int i = 0; i < 4; i++) *(u32x4*)(d_ + (128 + 64 * i) * GROW) = rb[i];
    }
    __syncthreads();
    {
      int kofs = min((kt + 1) * 32, K - 32);
      ra[0] = *(const u32x4*)(pa + kofs); ra[1] = *(const u32x4*)(pa + a64 + kofs);
#pragma unroll
      for (int i = 0; i < 4; i++) rb[i] = *(const u32x4*)(pb + (size_t)i * b64 + kofs);
    }
    bf16x8 af[4], bfr[8];
#pragma unroll
    for (int mi = 0; mi < 4; mi++) af[mi] = *(const bf16x8*)(sbase + raofs + mi * 16 * GROW);
#pragma unroll
    for (int ni = 0; ni < 8; ni++) bfr[ni] = *(const bf16x8*)(sbase + rbofs + ni * 16 * GROW);
#pragma unroll
    for (int mi = 0; mi < 4; mi++)
#pragma unroll
      for (int ni = 0; ni < 8; ni++)
        acc[mi][ni] = __builtin_amdgcn_mfma_f32_16x16x32_bf16(af[mi], bfr[ni], acc[mi][ni], 0, 0, 0);
  }
  asm volatile("s_nop 15\n\ts_nop 15" ::: "memory");
}

template <int NI>
__device__ __forceinline__ void zero_acc(f32x4 (&acc)[4][NI]) {
#pragma unroll
  for (int a = 0; a < 4; a++)
#pragma unroll
    for (int b = 0; b < NI; b++) acc[a][b] = f32x4{0.f, 0.f, 0.f, 0.f};
}

#define EPI_LOOP(BODY)                                                        \
  {                                                                           \
    const int _lane = tid & 63, _wid = tid >> 6;              \
    const int _wr = _wid >> 1, _wc = _wid & 1;                                \
    _Pragma("unroll") for (int mi = 0; mi < 4; mi++)                          \
    _Pragma("unroll") for (int ni = 0; ni < 4; ni++)                          \
    _Pragma("unroll") for (int j = 0; j < 4; j++) {                           \
      const int rl = _wr * 64 + mi * 16 + (_lane >> 4) * 4 + j;               \
      const int cl = _wc * 64 + ni * 16 + (_lane & 15);                       \
      BODY                                                                    \
    }                                                                         \
  }


__device__ __forceinline__ bool swz_tile(int r, int TM, int TN, int SR, int SC, int& tm, int& tn) {
  int b = blockIdx.x;
  int x = b & 7, j = b >> 3;
  int nsc = (TN + SC - 1) / SC, nsr = (TM + SR - 1) / SR;
  int s = r * 8 + x;
  if (s >= nsr * nsc || j >= SR * SC) return false;
  int sr = s / nsc, sc = s - sr * nsc;
  tm = sr * SR + j / SC;
  tn = sc * SC + j % SC;
  return tm < TM && tn < TN;
}
__device__ __forceinline__ int swz_rounds(int TM, int TN, int SR, int SC) {
  int nsc = (TN + SC - 1) / SC, nsr = (TM + SR - 1) / SR;
  return (nsr * nsc + 7) / 8;
}
#define FOR_TILES(TM, TN, SR, SC) for (int r_ = 0, nr_ = swz_rounds(TM, TN, SR, SC); r_ < nr_; r_++) if (int tm = 0, tn = 0; swz_tile(r_, TM, TN, SR, SC, tm, tn))

__device__ __forceinline__ int winperm_src(int n) {
  if (n < 768) return n;
  int r = n - 768;
  int T = r >> 7, rr = r & 127;
  int wc = rr >> 6, a = (rr >> 5) & 1, kind = (rr >> 4) & 1, i = rr & 15;
  int ch = T * 64 + wc * 32 + a * 16 + i;
  return 768 + kind * 256 + ch;
}

__device__ void transpose_tile(const float* __restrict__ src, int ld, int coloff, bool perm, int K,
                               bf16_t* __restrict__ dst, int nt, int kt, float* sm) {
  const int tid = otid();
  const int n0 = nt * 64, k0 = kt * 64;
  {
    int kk = tid >> 2, n16 = (tid & 3) * 16;
    int sc = perm ? winperm_src(n0 + n16) : (n0 + n16);
    const float* sp = src + (size_t)(k0 + kk) * ld + coloff + sc;
    const float* sq = sp + (size_t)64 * ld;
    float4 v0 = *(const float4*)(sp), v1 = *(const float4*)(sp + 4), v2 = *(const float4*)(sp + 8), v3 = *(const float4*)(sp + 12);
    float4 w0 = *(const float4*)(sq), w1 = *(const float4*)(sq + 4), w2 = *(const float4*)(sq + 8), w3 = *(const float4*)(sq + 12);
    __syncthreads();
    float* d = sm + kk * 65 + n16;
    d[0] = v0.x; d[1] = v0.y; d[2] = v0.z; d[3] = v0.w; d[4] = v1.x; d[5] = v1.y; d[6] = v1.z; d[7] = v1.w;
    d[8] = v2.x; d[9] = v2.y; d[10] = v2.z; d[11] = v2.w; d[12] = v3.x; d[13] = v3.y; d[14] = v3.z; d[15] = v3.w;
    float* e = d + 64 * 65;
    e[0] = w0.x; e[1] = w0.y; e[2] = w0.z; e[3] = w0.w; e[4] = w1.x; e[5] = w1.y; e[6] = w1.z; e[7] = w1.w;
    e[8] = w2.x; e[9] = w2.y; e[10] = w2.z; e[11] = w2.w; e[12] = w3.x; e[13] = w3.y; e[14] = w3.z; e[15] = w3.w;
  }
  __syncthreads();
  {
    int nn = tid >> 2, k32 = (tid & 3) * 32;
    unsigned o[16];
#pragma unroll
    for (int j = 0; j < 16; j++)
      o[j] = (unsigned)f2bf(sm[(k32 + 2 * j) * 65 + nn]) | ((unsigned)f2bf(sm[(k32 + 2 * j + 1) * 65 + nn]) << 16);
    u32x4* dp = (u32x4*)(dst + (size_t)(n0 + nn) * K + k0 + k32);
    dp[0] = u32x4{o[0], o[1], o[2], o[3]};
    dp[1] = u32x4{o[4], o[5], o[6], o[7]};
    dp[2] = u32x4{o[8], o[9], o[10], o[11]};
    dp[3] = u32x4{o[12], o[13], o[14], o[15]};
  }
}

#define TR_PER_LAYER 3952
#define N_TR (2 * (TR_PER_LAYER / 2))
#define N_MODP 768
#define N_XINIT 1056
#define N_S5D 16
#define N_TW 32
#define N_DFT 352
#define N_INITA (N_TR + N_MODP + N_XINIT + N_S5D + N_TW + N_DFT)

__device__ void phase_init_a(CParams& p, int item, char* smem) {
  const int tid = otid();
  if (item < N_TR) {
    int l = item / (TR_PER_LAYER / 2), t = (item % (TR_PER_LAYER / 2)) * 2;
    float* sm = (float*)smem;
    if (t < 320) {
      transpose_tile(p.w_in + (size_t)l * DM * DIN, DIN, 0, true, 1024, p.WinT + (size_t)l * 1280 * 1024, t / 16, t % 16, sm);
      return;
    }
    t -= 320;
    if (t < 1024) {
      transpose_tile(p.w_in + (size_t)l * DM * DIN, DIN, 1280, false, 1024, p.WgT + (size_t)l * 4096 * 1024, t / 16, t % 16, sm);
      return;
    }
    t -= 1024;
    if (t < 256) {
      int kb = t / 64, tt = t % 64;
      transpose_tile(p.w_branch + ((size_t)l * 4 + kb) * 256 * 1024, 1024, 0, false, 256,
                     p.WbT + ((size_t)l * 4 + kb) * 1024 * 256, tt / 4, tt % 4, sm);
      return;
    }
    t -= 256;
    if (t < 256) {
      transpose_tile(p.w_out + (size_t)l * DM * DM, DM, 0, false, 1024, p.WoT + (size_t)l * DM * DM, t / 16, t % 16, sm);
      return;
    }
    t -= 256;
    if (t < 1024) {
      transpose_tile(p.w1 + (size_t)l * DM * DFF, DFF, 0, false, 1024, p.W1T + (size_t)l * DFF * DM, t / 16, t % 16, sm);
      return;
    }
    t -= 1024;
    if (t < 1024) {
      transpose_tile(p.w2 + (size_t)l * DFF * DM, DM, 0, false, 4096, p.W2T + (size_t)l * DM * DFF, t / 64, t % 64, sm);
      return;
    }
    t -= 1024;
    {
      int which = t / 16, tt = t % 16;
      const float* src = which == 0 ? p.w_glu : (which == 1 ? p.fnet_w : p.conv_w_out);
      bf16_t* dst = which == 0 ? p.WgluT : (which == 1 ? p.WfnT : p.WcvT);
      transpose_tile(src + (size_t)l * 65536, 256, 0, false, 256, dst + (size_t)l * 65536, tt / 4, tt % 4, sm);
      return;
    }
  }
  item -= N_TR;
  if (item < N_MODP) {
    int l = item / 384, r = item % 384, nc = r / 16, kc = r % 16;
    float* sv = (float*)smem;
    __syncthreads();
    if (tid < 192) {
      int v = tid / 64, k = kc * 64 + (tid & 63);
      float cvv = v < 2 ? p.c[v * DM + k] : p.c_ctx[k];
      sv[tid] = cvv * sigmoidf_(cvv);
    }
    __syncthreads();
    int n = nc * 256 + tid;
    const float* w = p.w_mod + ((size_t)l * DM + kc * 64) * 6144 + n;
    float a0 = 0.f, a1 = 0.f, a2 = 0.f;
#pragma unroll 8
    for (int k = 0; k < 64; k++) {
      float wv = w[(size_t)k * 6144];
      a0 += sv[k] * wv; a1 += sv[64 + k] * wv; a2 += sv[128 + k] * wv;
    }
    float* dst = p.modp + ((size_t)(kc * 2 + l) * 3) * 6144 + n;
    dst[0] = a0; dst[6144] = a1; dst[2 * 6144] = a2;
    return;
  }
  item -= N_MODP;
  if (item < N_XINIT) {
    int d = tid * 4;
    int quarter = d >> 8;
    float fr[4];
#pragma unroll
    for (int e = 0; e < 4; e++) fr[e] = 1.0f / powf(10000.f, (float)((d + e) & 255) / 256.f);
    for (int i = 0; i < 16; i++) {
      int tok = item * 16 + i;
      if (tok < NLAT) {
        float4 xv = *(const float4*)(p.x + (size_t)tok * DM + d);
        int t = tok & 8191;
        float pos = (quarter < 2) ? (float)(t >> 6) : (float)(t & 63);
        float pe[4];
#pragma unroll
        for (int e = 0; e < 4; e++) {
          float ang = pos * fr[e];
          pe[e] = (quarter & 1) ? cosf(ang) : sinf(ang);
        }
        xv.x += pe[0]; xv.y += pe[1]; xv.z += pe[2]; xv.w += pe[3];
        *(float4*)(p.out + (size_t)tok * DM + d) = xv;
      } else {
        float4 xv = *(const float4*)(p.ctx + (size_t)(tok - NLAT) * DM + d);
        *(float4*)(p.xc + (size_t)(tok - NLAT) * DM + d) = xv;
      }
    }
    return;
  }
  item -= N_XINIT;
  if (item < N_S5D) {
    int idx = item * 256 + tid;
    float lre = p.lam_re[idx], lim = p.lam_im[idx];
    float dt = expf(p.log_dt[idx >> 6]);
    float mag = expf(lre * dt), ang = lim * dt;
    float are = mag * cosf(ang), aim = mag * sinf(ang);
    float den = lre * lre + lim * lim;
    float fre = ((are - 1.f) * lre + aim * lim) / den;
    float fim = (aim * lre - (are - 1.f) * lim) / den;
    p.Apar[idx] = make_float2(are, aim);
    for (int cc = 0; cc < 16; cc++) {
      float bre = p.b_re[(size_t)idx * 16 + cc], bim = p.b_im[(size_t)idx * 16 + cc];
      p.Bbar[(size_t)idx * 16 + cc] = make_float2(fre * bre - fim * bim, fre * bim + fim * bre);
    }
    return;
  }
  item -= N_S5D;
  if (item < N_TW) {
    int j = item * 256 + tid;
    float s, c;
    sincospif((float)j * (2.0f / 8192.0f), &s, &c);
    p.tw[j] = make_float2(c, -s);
    return;
  }
  item -= N_TW;
  {
    int e = item * 256 + tid;
    float sn, cs;
    if (e < 8192) {
      int n = e >> 6, c = e & 63;
      int wc = n >> 6, q = (n >> 4) & 3, i = n & 15;
      int a = q >> 1, ri = q & 1;
      int m = wc * 32 + a * 16 + i;
      sincospif((float)((m * c) & 63) * (2.0f / 64.0f), &sn, &cs);
      p.H3[e] = f2bf(ri == 0 ? cs : -sn);
    } else if (e < 8192 + 65536) {
      int ee = e - 8192;
      int row = ee >> 8, col = ee & 255;
      int k1 = row >> 1, ro = row & 1, t1 = col >> 1, ri = col & 1;
      sincospif((float)((k1 * t1) & 127) * (2.0f / 128.0f), &sn, &cs);
      float v = (ro == ri) ? cs : (ro == 0 ? sn : -sn);
      p.F1m[ee] = f2bf(v);
    } else {
      int ee = e - 8192 - 65536;
      int row = ee >> 7, col = ee & 127;
      float v = 0.f;
      if (row < 64) {
        int t2 = col >> 1, ri = col & 1;
        sincospif((float)((row * t2) & 63) * (2.0f / 64.0f), &sn, &cs);
        v = (ri == 0 ? cs : sn) * 0.001381067932f;
      }
      p.Gm[ee] = f2bf(v);
    }
  }
}

__device__ void phase_init_b(CParams& p, int item) {
  int o = item * 256 + otid();
  int n = o % 6144, l = o / (3 * 6144);
  float a = p.b_mod[l * 6144 + n];
  for (int kc = 0; kc < 16; kc++) a += p.modp[(size_t)kc * 2 * 3 * 6144 + o];
  p.mod[o] = a;
}

__device__ void phase_modulate(CParams& p, int l, int which, int item) {
  const int tid = otid();
  const int lane = tid & 63, wid = tid >> 6;
  int tok = item * 4 + wid;
  const float* xr = xrow(p, tok);
  const float* g = (which == 0 ? p.g1 : p.g2) + l * DM;
  const float* md = p.mod + ((size_t)l * 3 + modvec_of_tok(tok)) * 6144 + (which == 0 ? 0 : 3072);
  float4 v[4];
  float ss = 0.f;
  const bool pend = (tok >= NLAT) && ((l == 0 && which == 1) || (l == 1 && which == 0));
#pragma unroll
  for (int i = 0; i < 4; i++) {
    v[i] = *(const float4*)(xr + i * 256 + lane * 4);
    if (pend) {
      const float* pp = (const float*)p.YT1 + (size_t)(tok - NLAT) * DM + i * 256 + lane * 4;
#pragma unroll
      for (int k4 = 0; k4 < 4; k4++) {
        float4 q = *(const float4*)(pp + (size_t)k4 * 512 * DM);
        v[i].x += q.x; v[i].y += q.y; v[i].z += q.z; v[i].w += q.w;
      }
      *(float4*)(p.xc + (size_t)(tok - NLAT) * DM + i * 256 + lane * 4) = v[i];
    }
    ss += v[i].x * v[i].x + v[i].y * v[i].y + v[i].z * v[i].z + v[i].w * v[i].w;
  }
  ss = wave_sum(ss);
  float rstd = rsqrtf(ss * (1.f / DM) + 1e-6f);
#pragma unroll
  for (int i = 0; i < 4; i++) {
    int d = i * 256 + lane * 4;
    float4 gg = *(const float4*)(g + d);
    float4 sh = *(const float4*)(md + d);
    float4 sc = *(const float4*)(md + 1024 + d);
    float h0 = v[i].x * rstd * gg.x * (1.f + sc.x) + sh.x;
    float h1 = v[i].y * rstd * gg.y * (1.f + sc.y) + sh.y;
    float h2 = v[i].z * rstd * gg.z * (1.f + sc.z) + sh.z;
    float h3 = v[i].w * rstd * gg.w * (1.f + sc.w) + sh.w;
    uint2 o;
    o.x = (unsigned)f2bf(h0) | ((unsigned)f2bf(h1) << 16);
    o.y = (unsigned)f2bf(h2) | ((unsigned)f2bf(h3) << 16);
    *(uint2*)(p.hbuf + (size_t)tok * DM + d) = o;
  }
}

__device__ void phase_inproj(CParams& p, int l, int tm, int tn, char* smem) {
  const int tid = otid();
  bf16_t* sA = (bf16_t*)smem;
  bf16_t* sB = sA + 128 * LDSS;
  const bool lat = tm < 128;
  const int tbase = lat ? ((tm >> 6) * 8192 + (tm & 63)) : tm * 128;
  const int tstr = lat ? 64 : 1;
  f32x4 acc[4][4];
  zero_acc<4>(acc);
  gemm_mainloop<4>(p.hbuf + (size_t)tbase * DM, DM * tstr, p.WinT + ((size_t)l * 1280 + tn * 128) * 1024, 1024, 1024, sA, sB, acc, tid);
  if (tn < 6) {
    int cb = (tn & 1) * 128;
    if (lat && (tn == 2 || tn == 3)) {
      EPI_LOOP({ p.zfnP[(size_t)(tm * 128 + rl) * 256 + cb + cl] = f2bf(acc[mi][ni][j]); })
    } else {
      float* dst = tn < 2 ? p.zs5 : (tn < 4 ? p.zfn : p.zpl);
      EPI_LOOP({ dst[(size_t)(tbase + rl * tstr) * 256 + cb + cl] = acc[mi][ni][j]; })
    }
  } else {
    int T = tn - 6;
    const int lane = tid & 63, wid = tid >> 6, wr = wid >> 1, wc = wid & 1;
#pragma unroll
    for (int mi = 0; mi < 4; mi++)
#pragma unroll
      for (int a = 0; a < 2; a++)
#pragma unroll
        for (int j = 0; j < 4; j++) {
          int rl = wr * 64 + mi * 16 + (lane >> 4) * 4 + j;
          int ch = T * 64 + wc * 32 + a * 16 + (lane & 15);
          float val = acc[mi][2 * a][j], gt = acc[mi][2 * a + 1][j];
          p.zv[(size_t)(tbase + rl * tstr) * 256 + ch] = val * sigmoidf_(gt);
        }
  }
}

__device__ void phase_fn_step1(CParams& p, int item, char* smem) {
  const int tid = otid();
  bf16_t* sA = (bf16_t*)smem;
  bf16_t* sB = sA + 128 * LDSS;
  int tile = item >> 2, grp = item & 3;
  f32x4 acc[4][4];
  zero_acc<4>(acc);
  gemm_mainloop<4>(p.zfnP + (size_t)tile * 128 * 256 + grp * 64, 256, p.H3, 64, 64, sA, sB, acc, tid);
  const int lane = tid & 63, wid = tid >> 6, wr = wid >> 1, wc = wid & 1, l15 = lane & 15, lq = lane >> 4;
#pragma unroll
  for (int mi = 0; mi < 4; mi++)
#pragma unroll
    for (int a = 0; a < 2; a++) {
      int t1 = wr * 64 + mi * 16 + lq * 4;
      int ch = grp * 64 + wc * 32 + a * 16 + l15;
      u32x4 o;
      o[0] = (unsigned)f2bf(acc[mi][2 * a][0]) | ((unsigned)f2bf(acc[mi][2 * a + 1][0]) << 16);
      o[1] = (unsigned)f2bf(acc[mi][2 * a][1]) | ((unsigned)f2bf(acc[mi][2 * a + 1][1]) << 16);
      o[2] = (unsigned)f2bf(acc[mi][2 * a][2]) | ((unsigned)f2bf(acc[mi][2 * a + 1][2]) << 16);
      o[3] = (unsigned)f2bf(acc[mi][2 * a][3]) | ((unsigned)f2bf(acc[mi][2 * a + 1][3]) << 16);
      *(u32x4*)(p.ZT + ((size_t)tile * 256 + ch) * 256 + t1 * 2) = o;
    }
}
__device__ void phase_fn_step2(CParams& p, int item, char* smem) {
  const int tid = otid();
  bf16_t* sA = (bf16_t*)smem;
  bf16_t* sB = sA + 128 * LDSS;
  int tile = item >> 2, mt = (item >> 1) & 1, nt = item & 1;
  int seg = tile >> 6, t2 = tile & 63;
  f32x4 acc[4][4];
  zero_acc<4>(acc);
  gemm_mainloop<4>(p.F1m + (size_t)mt * 128 * 256, 256, p.ZT + ((size_t)tile * 256 + nt * 128) * 256, 256, 256, sA, sB, acc, tid);
  const int lane = tid & 63, wid = tid >> 6, wr = wid >> 1, wc = wid & 1, l15 = lane & 15, lq = lane >> 4;
  const float2* __restrict__ tw = p.tw;
#pragma unroll
  for (int mi = 0; mi < 4; mi++)
#pragma unroll
    for (int h = 0; h < 2; h++) {
      int k1 = mt * 64 + ((wr * 64 + mi * 16 + lq * 4) >> 1) + h;
      float2 w = tw[(t2 * k1) & 8191];
#pragma unroll
      for (int ni = 0; ni < 4; ni++) {
        float re = acc[mi][ni][2 * h], im = acc[mi][ni][2 * h + 1];
        float orr = re * w.x - im * w.y, oi = re * w.y + im * w.x;
        int ch = nt * 128 + wc * 64 + ni * 16 + l15;
        unsigned o = (unsigned)f2bf(orr) | ((unsigned)f2bf(oi) << 16);
        *(unsigned*)((seg ? p.YT1 : p.YT0) + (((size_t)t2 * 128 + k1) * 256 + ch) * 2) = o;
      }
    }
}
__device__ void phase_fn_step3(CParams& p, int item, char* smem) {
  const int tid = otid();
  bf16_t* sA = (bf16_t*)smem;
  bf16_t* sB = sA + 128 * LDSS;
  int sk = item >> 1, nt = item & 1;
  int seg = sk >> 7, k1 = sk & 127;
  const int lane = tid & 63, wid = tid >> 6, wr = wid >> 1, wc = wid & 1, l15 = lane & 15, lq = lane >> 4;
  f32x4 acc[4][4];
  zero_acc<4>(acc);
  const int lr = tid >> 3, lk = (tid & 7) * 8;
#pragma unroll 1
  for (int ks = 0; ks < 2; ks++) {
    u32x4 ra[4], rb[4];
#pragma unroll
    for (int i = 0; i < 4; i++) ra[i] = *(const u32x4*)(p.Gm + (size_t)(lr + i * 32) * 128 + ks * 64 + lk);
#pragma unroll
    for (int i = 0; i < 4; i++) {
      int idx = tid + i * 256;
      int t2l = idx >> 5, chq = (idx & 31) * 4;
      int t2 = ks * 32 + t2l;
      rb[i] = *(const u32x4*)((seg ? p.YT1 : p.YT0) + (((size_t)t2 * 128 + k1) * 256 + nt * 128 + chq) * 2);
    }
    __syncthreads();
#pragma unroll
    for (int i = 0; i < 4; i++) *(u32x4*)(sA + (lr + i * 32) * LDSS + lk) = ra[i];
#pragma unroll
    for (int i = 0; i < 4; i++) {
      int idx = tid + i * 256;
      int t2l = idx >> 5, chq = (idx & 31) * 4;
#pragma unroll
      for (int e = 0; e < 4; e++) *(unsigned*)(sB + (chq + e) * LDSS + t2l * 2) = rb[i][e];
    }
    __syncthreads();
#pragma unroll
    for (int k2s = 0; k2s < 2; k2s++) {
      bf16x8 af[4], bfr[4];
#pragma unroll
      for (int mi = 0; mi < 4; mi++) af[mi] = *(const bf16x8*)(sA + (wr * 64 + mi * 16 + l15) * LDSS + k2s * 32 + lq * 8);
#pragma unroll
      for (int ni = 0; ni < 4; ni++) bfr[ni] = *(const bf16x8*)(sB + (wc * 64 + ni * 16 + l15) * LDSS + k2s * 32 + lq * 8);
#pragma unroll
      for (int mi = 0; mi < 4; mi++)
#pragma unroll
        for (int ni = 0; ni < 4; ni++)
          acc[mi][ni] = __builtin_amdgcn_mfma_f32_16x16x32_bf16(af[mi], bfr[ni], acc[mi][ni], 0, 0, 0);
    }
  }
  asm volatile("s_nop 15\n\ts_nop 15" ::: "memory");
  if (wr == 0) {
#pragma unroll
    for (int mi = 0; mi < 4; mi++)
#pragma unroll
      for (int ni = 0; ni < 4; ni++)
#pragma unroll
        for (int j = 0; j < 4; j++) {
          int k2 = mi * 16 + lq * 4 + j;
          int ch = nt * 128 + wc * 64 + ni * 16 + l15;
          p.yfn[(size_t)(seg * 8192 + k1 + 128 * k2) * 256 + ch] = f2bf(acc[mi][ni][j]);
        }
  }
}

__device__ void phase_s5_pass1(CParams& p, int l, int item, char* smem) {
  const int tid = otid(), lane = tid & 63, wid = tid >> 6;
  int q = item >> 3, dir = (item >> 2) & 1, gq = item & 3;
  int g = gq * 4 + wid;
  float* us = (float*)smem + wid * 1024;
  int tok0 = q * 64;
  __syncthreads();
  {
    const float* src = p.zs5 + (size_t)(tok0 + lane) * 256 + g * 16;
#pragma unroll
    for (int i = 0; i < 4; i++) *(float4*)(us + lane * 16 + i * 4) = *(const float4*)(src + i * 4);
  }
  int pidx = ((l * 2 + dir) * 16 + g) * 64 + lane;
  float2 A = p.Apar[pidx];
  f32x2 bb[16];
#pragma unroll
  for (int cc = 0; cc < 16; cc++) {
    float2 b = p.Bbar[(size_t)pidx * 16 + cc];
    bb[cc] = f32x2{b.x, b.y};
  }
  __syncthreads();
  float hr = 0.f, hi = 0.f;
  for (int i = 0; i < 64; i++) {
    int t = dir == 0 ? i : 63 - i;
    float u[16];
#pragma unroll
    for (int k = 0; k < 4; k++) {
      float4 uv = *(const float4*)(us + t * 16 + k * 4);
      u[k * 4] = uv.x; u[k * 4 + 1] = uv.y; u[k * 4 + 2] = uv.z; u[k * 4 + 3] = uv.w;
    }
    f32x2 bu = {0.f, 0.f};
#pragma unroll
    for (int cc = 0; cc < 16; cc++) bu = __builtin_elementwise_fma(bb[cc], f32x2{u[cc], u[cc]}, bu);
    float nr = A.x * hr - A.y * hi + bu[0];
    float ni = A.x * hi + A.y * hr + bu[1];
    hr = nr; hi = ni;
  }
  p.E[(((size_t)q * 2 + dir) * 16 + g) * 64 + lane] = make_float2(hr, hi);
}

__device__ void phase_s5_carry(CParams& p, int l, int item) {
  int idx = item * 256 + otid();
  int b = idx >> 11, dir = (idx >> 10) & 1, gp = idx & 1023;
  float2 A = p.Apar[(l * 2 + dir) * 1024 + gp];
  float ar = A.x, ai = A.y;
#pragma unroll
  for (int s = 0; s < 6; s++) { float nr = ar * ar - ai * ai, ni = 2.f * ar * ai; ar = nr; ai = ni; }
  float hr = 0.f, hi = 0.f;
#pragma unroll 4
  for (int s = 0; s < 132; s++) {
    int q;
    if (dir == 0) q = s < 4 ? (256 + 4 * b + s) : (128 * b + (s - 4));
    else q = s < 4 ? (256 + 4 * b + 3 - s) : (128 * b + 127 - (s - 4));
    size_t o = ((size_t)q * 2 + dir) * 1024 + gp;
    float2 e = p.E[o];
    p.Hin[o] = make_float2(hr, hi);
    float nr = ar * hr - ai * hi + e.x;
    float ni = ar * hi + ai * hr + e.y;
    hr = nr; hi = ni;
  }
}

__device__ void phase_s5_pass2(CParams& p, int l, int item, char* smem) {
  const int tid = otid(), lane = tid & 63, wid = tid >> 6;
  int q = item >> 2, gq = item & 3;
  int g = gq * 4 + wid;
  float* us = (float*)smem + wid * 1024;
  bf16_t* hs = (bf16_t*)(smem + 16384) + wid * (16 * 136);
  int tok0 = q * 64;
  __syncthreads();
  {
    const float* src = p.zs5 + (size_t)(tok0 + lane) * 256 + g * 16;
#pragma unroll
    for (int i = 0; i < 4; i++) *(float4*)(us + lane * 16 + i * 4) = *(const float4*)(src + i * 4);
  }
  __syncthreads();
  f32x4 acc[4];
#pragma unroll
  for (int s = 0; s < 4; s++) acc[s] = f32x4{0.f, 0.f, 0.f, 0.f};
  const int l15 = lane & 15, lq = lane >> 4;
#pragma unroll
  for (int dir = 0; dir < 2; dir++) {
    int pidx = ((l * 2 + dir) * 16 + g) * 64 + lane;
    float2 A = p.Apar[pidx];
    f32x2 bb[16];
#pragma unroll
    for (int cc = 0; cc < 16; cc++) {
      float2 b = p.Bbar[(size_t)pidx * 16 + cc];
      bb[cc] = f32x2{b.x, b.y};
    }
    bf16x8 cf[4];
#pragma unroll
    for (int ks = 0; ks < 4; ks++) {
      int k = ks * 32 + lq * 8;
      bool im = k >= 64;
      const float* src = (im ? p.c_im : p.c_re) + ((((size_t)(l * 2 + dir) * 16 + g) * 16 + l15) * 64) + (k & 63);
      float4 v0 = *(const float4*)src, v1 = *(const float4*)(src + 4);
      float sgn = im ? -1.f : 1.f;
      cf[ks][0] = (short)f2bf(sgn * v0.x); cf[ks][1] = (short)f2bf(sgn * v0.y);
      cf[ks][2] = (short)f2bf(sgn * v0.z); cf[ks][3] = (short)f2bf(sgn * v0.w);
      cf[ks][4] = (short)f2bf(sgn * v1.x); cf[ks][5] = (short)f2bf(sgn * v1.y);
      cf[ks][6] = (short)f2bf(sgn * v1.z); cf[ks][7] = (short)f2bf(sgn * v1.w);
    }
    float2 h0 = p.Hin[(((size_t)q * 2 + dir) * 16 + g) * 64 + lane];
    float hr = h0.x, hi = h0.y;
#pragma unroll
    for (int s = 0; s < 4; s++) {
      const int sb = dir == 0 ? s : 3 - s;
      for (int i = 0; i < 16; i++) {
        int tl = dir == 0 ? i : 15 - i;
        int t = sb * 16 + tl;
        float u[16];
#pragma unroll
        for (int k = 0; k < 4; k++) {
          float4 uv = *(const float4*)(us + t * 16 + k * 4);
          u[k * 4] = uv.x; u[k * 4 + 1] = uv.y; u[k * 4 + 2] = uv.z; u[k * 4 + 3] = uv.w;
        }
        f32x2 bu = {0.f, 0.f};
#pragma unroll
        for (int cc = 0; cc < 16; cc++) bu = __builtin_elementwise_fma(bb[cc], f32x2{u[cc], u[cc]}, bu);
        float nr = A.x * hr - A.y * hi + bu[0];
        float ni = A.x * hi + A.y * hr + bu[1];
        hr = nr; hi = ni;
        hs[tl * 136 + lane] = f2bf(hr);
        hs[tl * 136 + 64 + lane] = f2bf(hi);
      }
      __syncthreads();
#pragma unroll
      for (int ks = 0; ks < 4; ks++) {
        bf16x8 a = *(const bf16x8*)(hs + l15 * 136 + ks * 32 + lq * 8);
        acc[sb] = __builtin_amdgcn_mfma_f32_16x16x32_bf16(a, cf[ks], acc[sb], 0, 0, 0);
      }
      __syncthreads();
    }
  }
  asm volatile("s_nop 15\n\ts_nop 15" ::: "memory");
  float dd = p.s5d[l * 256 + g * 16 + l15];
#pragma unroll
  for (int sb = 0; sb < 4; sb++)
#pragma unroll
    for (int j = 0; j < 4; j++) {
      int t = sb * 16 + lq * 4 + j;
      float y = acc[sb][j] + dd * us[t * 16 + l15];
      float z = 0.7978845608028654f * (y + 0.044715f * y * y * y);
      float ge = y / (1.f + __expf(-2.f * z));
      p.ys[(size_t)(tok0 + t) * 256 + g * 16 + l15] = f2bf(ge);
    }
}

__device__ void phase_fnet1(CParams& p, int item) {
  const int ch = otid();
  int segbase, N1, m1, m2, t2, k1b;
  if (item < 1024) {
    int seg = item >> 9; t2 = (item >> 3) & 63; k1b = (item & 7) * 16;
    segbase = seg * 8192; N1 = 128; m1 = 64; m2 = 1;
  } else {
    int it = item - 1024;
    int seg = it >> 6; t2 = it & 63; k1b = 0;
    segbase = NLAT + seg * 256; N1 = 4; m1 = 2048; m2 = 32;
  }
  float are[16], aim[16];
#pragma unroll
  for (int k = 0; k < 16; k++) { are[k] = 0.f; aim[k] = 0.f; }
  const float* src = p.zfn + (size_t)(segbase + t2) * 256 + ch;
  const float2* __restrict__ tw = p.tw;
  for (int t1 = 0; t1 < N1; t1++) {
    float u = src[(size_t)t1 * 64 * 256];
#pragma unroll
    for (int k = 0; k < 16; k++) {
      float2 w = tw[((k1b + k) * t1 * m1) & 8191];
      are[k] += u * w.x; aim[k] += u * w.y;
    }
  }
#pragma unroll
  for (int k = 0; k < 16; k++) {
    int k1 = k1b + k;
    if (k1 < N1) {
      float2 w = tw[(t2 * k1 * m2) & 8191];
      float re = are[k] * w.x - aim[k] * w.y;
      float im = are[k] * w.y + aim[k] * w.x;
      p.out1[(size_t)(segbase + k1 * 64 + t2) * 256 + ch] = make_float2(re, im);
    }
  }
}

__device__ void phase_fnet2(CParams& p, int item, char* smem) {
  const int tid = otid();
  int segbase, N1, k1, k2b;
  float scale;
  if (item < 1024) {
    int seg = item >> 9; k1 = (item >> 2) & 127; k2b = (item & 3) * 16;
    segbase = seg * 8192; N1 = 128; scale = 0.001381067932f;
  } else {
    int it = item - 1024;
    int seg = it >> 4; k1 = (it >> 2) & 3; k2b = (it & 3) * 16;
    segbase = NLAT + seg * 256; N1 = 4; scale = 0.0078125f;
  }
  float2* sbuf = (float2*)smem;
  float2* tw64 = (float2*)(smem + 32768);
  const float2* __restrict__ tw = p.tw;
  float are[16], aim[16];
#pragma unroll
  for (int k = 0; k < 16; k++) { are[k] = 0.f; aim[k] = 0.f; }
  const float2* src = p.out1 + (size_t)(segbase + k1 * 64) * 256 + tid;
  for (int t2 = 0; t2 < 64; t2++) {
    float2 v = src[(size_t)t2 * 256];
#pragma unroll
    for (int k = 0; k < 16; k++) {
      float2 w = tw[((k2b + k) * t2 * 128) & 8191];
      are[k] += v.x * w.x - v.y * w.y;
      aim[k] += v.x * w.y + v.y * w.x;
    }
  }
  __syncthreads();
#pragma unroll
  for (int k = 0; k < 16; k++) sbuf[k * 256 + tid] = make_float2(are[k], aim[k]);
  if (tid < 64) tw64[tid] = tw[tid * 128];
  __syncthreads();
  int grp = tid >> 6, m = tid & 63;
  float o[16];
#pragma unroll
  for (int k = 0; k < 16; k++) o[k] = 0.f;
  for (int cc = 0; cc < 64; cc++) {
    float2 w = tw64[(m * cc) & 63];
#pragma unroll
    for (int k = 0; k < 16; k++) {
      float2 v = sbuf[k * 256 + grp * 64 + cc];
      o[k] += v.x * w.x - v.y * w.y;
    }
  }
#pragma unroll
  for (int k = 0; k < 16; k++) {
    int tok = segbase + k1 + N1 * (k2b + k);
    p.yfn[(size_t)tok * 256 + tid] = f2bf(o[k] * scale);
  }
}

__device__ void phase_conv(CParams& p, int l, int item, char* smem) {
  const int tid = otid(), lane = tid & 63, wid = tid >> 6;
  int t0 = item * 16;
  int s0, s1;
  seg_bounds(t0, s0, s1);
  float* yb = (float*)smem;
  float w[31];
#pragma unroll
  for (int j = 0; j < 31; j++) w[j] = p.conv_w[((size_t)l * 31 + j) * 256 + tid];
  float acc[16];
  float bias = p.conv_b[l * 256 + tid];
#pragma unroll
  for (int i = 0; i < 16; i++) acc[i] = bias;
#pragma unroll
  for (int m = 0; m < 46; m++) {
    int tok = t0 - 15 + m;
    float v = (tok >= s0 && tok < s1) ? p.zv[(size_t)tok * 256 + tid] : 0.f;
#pragma unroll
    for (int i = 0; i < 16; i++) {
      if (m - i >= 0 && m - i <= 30) acc[i] += w[m - i] * v;
    }
  }
  __syncthreads();
#pragma unroll
  for (int i = 0; i < 16; i++) yb[i * 256 + tid] = acc[i];
  __syncthreads();
  float4 gg = *(const float4*)(p.ln_g + l * 256 + lane * 4);
  float4 bb = *(const float4*)(p.ln_b + l * 256 + lane * 4);
#pragma unroll
  for (int r = 0; r < 4; r++) {
    int i = wid * 4 + r;
    float4 v = *(const float4*)(yb + i * 256 + lane * 4);
    float mu = wave_sum(v.x + v.y + v.z + v.w) * (1.f / 256.f);
    float d0 = v.x - mu, d1 = v.y - mu, d2 = v.z - mu, d3 = v.w - mu;
    float var = wave_sum(d0 * d0 + d1 * d1 + d2 * d2 + d3 * d3) * (1.f / 256.f);
    float rs = rsqrtf(var + 1e-6f);
    float y0 = d0 * rs * gg.x + bb.x, y1 = d1 * rs * gg.y + bb.y, y2 = d2 * rs * gg.z + bb.z, y3 = d3 * rs * gg.w + bb.w;
    y0 *= sigmoidf_(y0); y1 *= sigmoidf_(y1); y2 *= sigmoidf_(y2); y3 *= sigmoidf_(y3);
    uint2 o;
    o.x = (unsigned)f2bf(y0) | ((unsigned)f2bf(y1) << 16);
    o.y = (unsigned)f2bf(y2) | ((unsigned)f2bf(y3) << 16);
    *(uint2*)(p.cv + (size_t)(t0 + i) * 256 + lane * 4) = o;
  }
}

__device__ void phase_pool(CParams& p, int l, int item, char* smem) {
  const int tid = otid();
  int t0 = item * 16;
  int s0, s1;
  seg_bounds(t0, s0, s1);
  float* pl = (float*)smem;
  int grp = tid >> 6, d = tid & 63;
  int half = 1 << grp;
  const float* zp = p.zpl + tid;
  __syncthreads();
  {
    float s = 0.f;
    for (int w = 0; w < 2 * half; w++) {
      int tt = t0 - half + w;
      s += (tt >= s0 && tt < s1) ? zp[(size_t)tt * 256] : 0.f;
    }
#pragma unroll
    for (int i = 0; i < 16; i++) {
      int t = t0 + i;
      int lo = max(t - half, s0), hi = min(t + half, s1);
      pl[i * 256 + tid] = s / (float)(hi - lo) - zp[(size_t)t * 256];
      int ta = t + half, tr = t - half;
      float va = (ta < s1) ? zp[(size_t)ta * 256] : 0.f;
      float vr = (tr >= s0) ? zp[(size_t)tr * 256] : 0.f;
      s += va - vr;
    }
  }
  __syncthreads();
  float acc[16];
#pragma unroll
  for (int i = 0; i < 16; i++) acc[i] = 0.f;
  const float* wp = p.pool_w + ((size_t)(l * 4 + grp) * 64) * 64 + d;
  for (int cc = 0; cc < 64; cc += 4) {
    float w0 = wp[cc * 64], w1 = wp[(cc + 1) * 64], w2 = wp[(cc + 2) * 64], w3 = wp[(cc + 3) * 64];
#pragma unroll
    for (int i = 0; i < 16; i++) {
      float4 pv = *(const float4*)(pl + i * 256 + grp * 64 + cc);
      acc[i] += pv.x * w0 + pv.y * w1 + pv.z * w2 + pv.w * w3;
    }
  }
  float sc = p.pool_scale[l * 256 + tid];
#pragma unroll
  for (int i = 0; i < 16; i++) p.br[(size_t)(t0 + i) * 1024 + 512 + tid] = f2bf(acc[i] * sc);
}

__device__ void phase_small(CParams& p, int l, int item, char* smem) {
  const int tid = otid();
  bf16_t* sA = (bf16_t*)smem;
  bf16_t* sB = sA + 128 * LDSS;
  int which = item / 264, r = item % 264, tm = r >> 1, tn = r & 1;
  int row0 = tm * 128, col0 = tn * 128;
  const bf16_t* A = which == 0 ? p.ys : (which == 1 ? p.yfn : p.cv);
  const bf16_t* B = (which == 0 ? p.WgluT : (which == 1 ? p.WfnT : p.WcvT)) + (size_t)l * 65536;
  f32x4 acc[4][4];
  zero_acc<4>(acc);
  gemm_mainloop<4>(A + (size_t)row0 * 256, 256, B + (size_t)col0 * 256, 256, 256, sA, sB, acc, tid);
  if (which == 0) {
    EPI_LOOP({
      float y = bf2f(p.ys[(size_t)(row0 + rl) * 256 + col0 + cl]);
      p.br[(size_t)(row0 + rl) * 1024 + col0 + cl] = f2bf(y * sigmoidf_(acc[mi][ni][j]));
    })
  } else {
    int cb = which == 1 ? 256 : 768;
    EPI_LOOP({ p.br[(size_t)(row0 + rl) * 1024 + cb + col0 + cl] = f2bf(acc[mi][ni][j]); })
  }
}

template <int NI>
__device__ void phase_merge(CParams& p, int l, int tm, int tn, char* smem) {
  const int tid = otid();
  bf16_t* sA = (bf16_t*)smem;
  bf16_t* sB = sA + 128 * LDSS;
  int row0 = tm * 128, col0 = tn * (32 * NI);
  f32x4 mer[4][NI];
  zero_acc<NI>(mer);
#pragma unroll 1
  for (int kb0 = 0; kb0 < 4; kb0++) {
    int kb = kb0;
    asm volatile("" : "+s"(kb));
    int tid2 = tid;
    asm volatile("" : "+v"(tid2));
    unsigned pk[4][NI][2];
    {
      f32x4 acc[4][NI];
      zero_acc<NI>(acc);
      gemm_mainloop<NI>(p.br + (size_t)row0 * 1024 + kb * 256, 1024,
                        p.WbT + (((size_t)l * 4 + kb) * 1024 + col0) * 256, 256, 256, sA, sB, acc, tid2);
#pragma unroll
      for (int mi = 0; mi < 4; mi++)
#pragma unroll
        for (int ni = 0; ni < NI; ni++) {
          pk[mi][ni][0] = (unsigned)f2bf(acc[mi][ni][0]) | ((unsigned)f2bf(acc[mi][ni][1]) << 16);
          pk[mi][ni][1] = (unsigned)f2bf(acc[mi][ni][2]) | ((unsigned)f2bf(acc[mi][ni][3]) << 16);
        }
    }
    f32x4 acc[4][NI];
    zero_acc<NI>(acc);
    asm volatile("" : "+v"(tid2));
    gemm_mainloop<NI>(p.hbuf + (size_t)row0 * DM, DM,
                      p.WgT + (((size_t)l * 4 + kb) * 1024 + col0) * 1024, 1024, 1024, sA, sB, acc, tid2);
#pragma unroll
    for (int mi = 0; mi < 4; mi++)
#pragma unroll
      for (int ni = 0; ni < NI; ni++) {
        unsigned p0 = pk[mi][ni][0], p1 = pk[mi][ni][1];
        mer[mi][ni][0] += sigmoidf_(acc[mi][ni][0]) * __uint_as_float(p0 << 16);
        mer[mi][ni][1] += sigmoidf_(acc[mi][ni][1]) * __uint_as_float(p0 & 0xffff0000u);
        mer[mi][ni][2] += sigmoidf_(acc[mi][ni][2]) * __uint_as_float(p1 << 16);
        mer[mi][ni][3] += sigmoidf_(acc[mi][ni][3]) * __uint_as_float(p1 & 0xffff0000u);
      }
  }
  {
    const int lane = tid & 63, wid = tid >> 6, wr = wid >> 1, wc = wid & 1;
#pragma unroll
    for (int mi = 0; mi < 4; mi++)
#pragma unroll
      for (int ni = 0; ni < NI; ni++)
#pragma unroll
        for (int j = 0; j < 4; j++) {
          int rl = wr * 64 + mi * 16 + (lane >> 4) * 4 + j;
          int cl = wc * (16 * NI) + ni * 16 + (lane & 15);
          p.merged[(size_t)(row0 + rl) * 1024 + col0 + cl] = f2bf(mer[mi][ni][j]);
        }
  }
}

__device__ void phase_merge4(CParams& p, int l, int tm, int tn, char* smem) {
  const int tid = otid();
  bf16_t* sA = (bf16_t*)smem;
  bf16_t* sB = sA + 128 * LDSS;
  int row0 = tm * 128, col0 = tn * 128;
  unsigned mer[4][4][2];
#pragma unroll
  for (int mi = 0; mi < 4; mi++)
#pragma unroll
    for (int ni = 0; ni < 4; ni++) { mer[mi][ni][0] = 0u; mer[mi][ni][1] = 0u; }
#pragma unroll 1
  for (int kb0 = 0; kb0 < 4; kb0++) {
    int kb = kb0;
    asm volatile("" : "+s"(kb));
    int tid2 = tid;
    asm volatile("" : "+v"(tid2));
    unsigned pk[4][4][2];
    {
      f32x4 acc[4][4];
      zero_acc<4>(acc);
      gemm_mainloop<4>(p.br + (size_t)row0 * 1024 + kb * 256, 1024,
                       p.WbT + (((size_t)l * 4 + kb) * 1024 + col0) * 256, 256, 256, sA, sB, acc, tid2);
#pragma unroll
      for (int mi = 0; mi < 4; mi++)
#pragma unroll
        for (int ni = 0; ni < 4; ni++) {
          pk[mi][ni][0] = (unsigned)f2bf(acc[mi][ni][0]) | ((unsigned)f2bf(acc[mi][ni][1]) << 16);
          pk[mi][ni][1] = (unsigned)f2bf(acc[mi][ni][2]) | ((unsigned)f2bf(acc[mi][ni][3]) << 16);
        }
    }
    f32x4 acc[4][4];
    zero_acc<4>(acc);
    asm volatile("" : "+v"(tid2));
    gemm_mainloop<4>(p.hbuf + (size_t)row0 * DM, DM,
                     p.WgT + (((size_t)l * 4 + kb) * 1024 + col0) * 1024, 1024, 1024, sA, sB, acc, tid2);
#pragma unroll
    for (int mi = 0; mi < 4; mi++)
#pragma unroll
      for (int ni = 0; ni < 4; ni++) {
        unsigned p0 = pk[mi][ni][0], p1 = pk[mi][ni][1], m0 = mer[mi][ni][0], m1 = mer[mi][ni][1];
        float r0 = __uint_as_float(m0 << 16) + sigmoidf_(acc[mi][ni][0]) * __uint_as_float(p0 << 16);
        float r1 = __uint_as_float(m0 & 0xffff0000u) + sigmoidf_(acc[mi][ni][1]) * __uint_as_float(p0 & 0xffff0000u);
        float r2 = __uint_as_float(m1 << 16) + sigmoidf_(acc[mi][ni][2]) * __uint_as_float(p1 << 16);
        float r3 = __uint_as_float(m1 & 0xffff0000u) + sigmoidf_(acc[mi][ni][3]) * __uint_as_float(p1 & 0xffff0000u);
        mer[mi][ni][0] = (unsigned)f2bf(r0) | ((unsigned)f2bf(r1) << 16);
        mer[mi][ni][1] = (unsigned)f2bf(r2) | ((unsigned)f2bf(r3) << 16);
      }
  }
  {
    const int lane = tid & 63, wid = tid >> 6, wr = wid >> 1, wc = wid & 1;
#pragma unroll
    for (int mi = 0; mi < 4; mi++)
#pragma unroll
      for (int ni = 0; ni < 4; ni++)
#pragma unroll
        for (int j = 0; j < 4; j++) {
          int rl = wr * 64 + mi * 16 + (lane >> 4) * 4 + j;
          int cl = wc * 64 + ni * 16 + (lane & 15);
          unsigned w = mer[mi][ni][j >> 1];
          p.merged[(size_t)(row0 + rl) * 1024 + col0 + cl] = (bf16_t)((j & 1) ? (w >> 16) : (w & 0xffffu));
        }
  }
}

__device__ void phase_proj_res(CParams& p, int l, int tm, int tn, char* smem, const bf16_t* A, int K,
                               const bf16_t* Bt, int gate_off, float gscale) {
  const int tid = otid();
  bf16_t* sA = (bf16_t*)smem;
  bf16_t* sB = sA + 128 * LDSS;
  int row0 = tm * 128, col0 = tn * 128;
  f32x4 acc[4][4];
  zero_acc<4>(acc);
  gemm_mainloop<4>(A + (size_t)row0 * K, K, Bt + (size_t)col0 * K, K, K, sA, sB, acc, tid);
  const float* md = p.mod + ((size_t)l * 3 + modvec_of_tok(row0)) * 6144 + gate_off;
  EPI_LOOP({
    float* xp = xrow(p, row0 + rl) + col0 + cl;
    *xp = *xp + gscale * md[col0 + cl] * acc[mi][ni][j];
  })
}

__device__ void phase_proj_res_ctx(CParams& p, int l, int item, char* smem, const bf16_t* A, int K,
                                   const bf16_t* Bt, int gate_off) {
  const int tid = otid();
  bf16_t* sA = (bf16_t*)smem;
  bf16_t* sB = sA + 128 * LDSS;
  int ks = item & 3, tn = (item >> 2) & 7, tmc = item >> 5;
  int row0 = NLAT + tmc * 128, col0 = tn * 128;
  int kc = K >> 2;
  f32x4 acc[4][4];
  zero_acc<4>(acc);
  gemm_mainloop<4>(A + (size_t)row0 * K + ks * kc, K, Bt + (size_t)col0 * K + ks * kc, K, kc, sA, sB, acc, tid);
  const float* md = p.mod + ((size_t)l * 3 + 2) * 6144 + gate_off;
  float* part = (float*)p.YT1 + (size_t)ks * 512 * DM;
  EPI_LOOP({ part[(size_t)(row0 - NLAT + rl) * DM + col0 + cl] = md[col0 + cl] * acc[mi][ni][j]; })
}

__device__ void phase_mlp1_big(CParams& p, int l, int tm, int tn, char* smem) {
  const int tid = otid();
  int row0 = tm * 128, col0 = tn * 256;
  f32x4 acc[4][8];
  zero_acc<8>(acc);
  gemm_mainloop8(p.hbuf + (size_t)row0 * DM, DM, p.W1T + ((size_t)l * DFF + col0) * DM, DM, DM, (bf16_t*)smem, acc, tid);
  const int lane = tid & 63, wid = tid >> 6, wr = wid >> 1, wc = wid & 1;
#pragma unroll
  for (int mi = 0; mi < 4; mi++)
#pragma unroll
    for (int ni = 0; ni < 8; ni++)
#pragma unroll
      for (int j = 0; j < 4; j++) {
        int rl = wr * 64 + mi * 16 + (lane >> 4) * 4 + j;
        int cl = wc * 128 + ni * 16 + (lane & 15);
        float a = fmaxf(acc[mi][ni][j], 0.f);
        p.hidden[(size_t)(row0 + rl) * DFF + col0 + cl] = f2bf(a * a);
      }
}

__device__ void phase_mlp1(CParams& p, int l, int tm, int tn, char* smem) {
  const int tid = otid();
  bf16_t* sA = (bf16_t*)smem;
  bf16_t* sB = sA + 128 * LDSS;
  int row0 = tm * 128, col0 = tn * 128;
  f32x4 acc[4][4];
  zero_acc<4>(acc);
  gemm_mainloop<4>(p.hbuf + (size_t)row0 * DM, DM, p.W1T + ((size_t)l * DFF + col0) * DM, DM, DM, sA, sB, acc, tid);
  EPI_LOOP({
    float a = fmaxf(acc[mi][ni][j], 0.f);
    p.hidden[(size_t)(row0 + rl) * DFF + col0 + cl] = f2bf(a * a);
  })
}

__device__ void phase_final(CParams& p, int item) {
  const int tid = otid();
  const int lane = tid & 63, wid = tid >> 6;
  int tok = item * 4 + wid;
  float* xr = p.out + (size_t)tok * DM;
  float4 v[4];
  float ss = 0.f;
#pragma unroll
  for (int i = 0; i < 4; i++) {
    v[i] = *(const float4*)(xr + i * 256 + lane * 4);
    ss += v[i].x * v[i].x + v[i].y * v[i].y + v[i].z * v[i].z + v[i].w * v[i].w;
  }
  ss = wave_sum(ss);
  float rstd = rsqrtf(ss * (1.f / DM) + 1e-6f);
#pragma unroll
  for (int i = 0; i < 4; i++) {
    int d = i * 256 + lane * 4;
    float4 gg = *(const float4*)(p.g_final + d);
    float4 o;
    o.x = v[i].x * rstd * gg.x; o.y = v[i].y * rstd * gg.y; o.z = v[i].z * rstd * gg.z; o.w = v[i].w * rstd * gg.w;
    *(float4*)(xr + d) = o;
  }
}


#define XB_TMO      128
#define XB_XCNT(j)  (256  + 64 * (j))
#define XB_XSUB(j)  (1280 + 64 * (j))
#define XB_XGEN(j)  (2304 + 64 * (j))
#define XB_TOP      3328
#define XB_TOPGEN   3392
#define XCD_BAR_WORDS 3456
#define XB_SPIN_CAP (1u << 20)
#define LAS __attribute__((address_space(3)))
__device__ __forceinline__ unsigned xb_ld(unsigned* p)              { return __hip_atomic_load(p, __ATOMIC_RELAXED, __HIP_MEMORY_SCOPE_AGENT); }
__device__ __forceinline__ unsigned xb_add(unsigned* p, unsigned v) { return __hip_atomic_fetch_add(p, v, __ATOMIC_RELAXED, __HIP_MEMORY_SCOPE_AGENT); }
__device__ __forceinline__ unsigned xb_xcc_id() { return (unsigned)__builtin_amdgcn_s_getreg((3 << 11) | 20) & 0xFu; }
#define XB_SPIN(cond, bar) do { unsigned _sp = 0; while (cond) { __builtin_amdgcn_s_sleep(1); \
    if ((++_sp & 255u) == 0u) { if (xb_ld(&(bar)[XB_TMO])) break; if (_sp > XB_SPIN_CAP) { atomicAdd(&(bar)[XB_TMO], 1u); break; } } } } while (0)
struct XcdBarrier { unsigned* bar; unsigned x; volatile LAS unsigned* st; };
__device__ __forceinline__ XcdBarrier xcd_barrier_post(unsigned* bar, volatile LAS unsigned* st) {
  XcdBarrier b; b.bar = bar; b.x = xb_xcc_id(); b.st = st;
  if (threadIdx.x == 0) (void)xb_add(&bar[XB_XCNT(b.x)], 1u);
  return b;
}
__device__ __forceinline__ void xcd_barrier_complete(unsigned* bar, unsigned x, unsigned& nloc, unsigned& nx) {
  const unsigned G = gridDim.x * gridDim.y * gridDim.z;
  unsigned sum, cnt, mine, sp = 0u;
  for (;;) {
    sum = 0u; cnt = 0u; mine = 0u;
#pragma unroll
    for (unsigned j = 0; j < 16; ++j) { const unsigned c = xb_ld(&bar[XB_XCNT(j)]); sum += c; cnt += (c > 0u) ? 1u : 0u; mine = (j == x) ? c : mine; }
    if (sum == G) break;
    __builtin_amdgcn_s_sleep(1);
    if ((++sp & 255u) == 0u) { if (xb_ld(&bar[XB_TMO])) break; if (sp > XB_SPIN_CAP) { atomicAdd(&bar[XB_TMO], 1u); break; } }
  }
  nloc = mine > 0u ? mine : 1u; nx = cnt > 0u ? cnt : 1u;
}
__device__ __forceinline__ void xcd_barrier(const XcdBarrier& b) {
  asm volatile("s_waitcnt vmcnt(0)" ::: "memory");
  __syncthreads();
  if (threadIdx.x == 0) {
    unsigned* bar = b.bar;
    __builtin_amdgcn_s_waitcnt(0);
    unsigned nloc = b.st[0], nx = b.st[1];
    if (nloc == 0u) { xcd_barrier_complete(bar, b.x, nloc, nx); b.st[0] = nloc; b.st[1] = nx; }
    const unsigned old = xb_add(&bar[XB_XSUB(b.x)], 1u);
    const unsigned gen = old / nloc;
    if (old + 1u == (gen + 1u) * nloc) {
      __builtin_amdgcn_fence(__ATOMIC_RELEASE, "agent");
      asm volatile("s_waitcnt vmcnt(0)" ::: "memory");
      const unsigned og = xb_add(&bar[XB_TOP], 1u);
      const unsigned tg = og / nx;
      if (og + 1u == (tg + 1u) * nx) xb_add(&bar[XB_TOPGEN], 1u);
      else XB_SPIN(xb_ld(&bar[XB_TOPGEN]) == tg, bar);
      __builtin_amdgcn_fence(__ATOMIC_ACQUIRE, "agent");
      xb_add(&bar[XB_XGEN(b.x)], 1u);
      asm volatile("s_waitcnt vmcnt(0)" ::: "memory");
    } else {
      XB_SPIN(xb_ld(&bar[XB_XGEN(b.x)]) == gen, bar);
      __builtin_amdgcn_fence(__ATOMIC_ACQUIRE, "agent");
      asm volatile("s_waitcnt vmcnt(0)" ::: "memory");
    }
  }
  __syncthreads();
}

#define FOR_ITEMS(N) for (int item = blockIdx.x; item < (N); item += gridDim.x)

#ifndef PROBE_DUP
#define PROBE_DUP 0
#endif
#define REPS(k) for (int rep = 0; rep < ((PROBE_DUP == (k)) ? 2 : 1); rep++)

__global__ void __launch_bounds__(256, 2) fwd_megakernel(Params p_unused) {
  cg::grid_group grid = cg::this_grid();
  __shared__ __attribute__((aligned(16))) char smem[SMEM_BYTES];
  __shared__ uint4 xb_words;
  if (threadIdx.x == 0) xb_words = make_uint4(0u, 0u, 0u, 0u);
  __syncthreads();
  XcdBarrier xb = xcd_barrier_post(kparams().bar, (volatile LAS unsigned*)&xb_words);

  REPS(5) {
    { CParams& p = kparams(); FOR_ITEMS(N_INITA) phase_init_a(p, item, smem); }
    if (kparams().bar == nullptr) grid.sync();
    xcd_barrier(xb);
    { CParams& p = kparams(); FOR_ITEMS(144) phase_init_b(p, item); }
    xcd_barrier(xb);
  }

#pragma unroll 1
  for (int l0 = 0; l0 < 2; l0++) {
    int l = l0;
    asm volatile("" : "+s"(l));
    REPS(6) {
      { CParams& p = kparams(); FOR_ITEMS(4224) phase_modulate(p, l, 0, item); }
      xcd_barrier(xb);
    }
    REPS(1) {
      { CParams& p = kparams(); FOR_TILES(132, 10, 6, 10) phase_inproj(p, l, tm, tn, smem); }
      xcd_barrier(xb);
    }
    REPS(2) {
      { CParams& p = kparams();
        FOR_ITEMS(512 + 128 + 2112) {
          if (item < 512) phase_fn_step1(p, item, smem);
          else if (item < 640) phase_fnet1(p, item - 512 + 1024);
          else phase_s5_pass1(p, l, item - 640, smem);
        }
      }
      xcd_barrier(xb);
    }
    REPS(3) {
      { CParams& p = kparams();
        FOR_ITEMS(16 + 32 + 1056) {
          if (item < 16) phase_s5_carry(p, l, item);
          else if (item < 48) phase_fnet2(p, item - 16 + 1024, smem);
          else phase_conv(p, l, item - 48, smem);
        }
      }
      xcd_barrier(xb);
      { CParams& p = kparams(); FOR_ITEMS(512) phase_fn_step2(p, item, smem); }
      xcd_barrier(xb);
    }
    REPS(4) {
      { CParams& p = kparams();
        FOR_ITEMS(2112 + 512) {
          if (item < 1056) phase_s5_pass2(p, l, item, smem);
          else if (item < 2112) phase_pool(p, l, item - 1056, smem);
          else phase_fn_step3(p, item - 2112, smem);
        }
      }
      xcd_barrier(xb);
      { CParams& p = kparams(); FOR_ITEMS(792) phase_small(p, l, item, smem); }
      xcd_barrier(xb);
    }
    REPS(8) {
      { CParams& p = kparams();
        FOR_TILES(128, 8, 8, 8) phase_merge4(p, l, tm, tn, smem);
        if (l == 0) { FOR_ITEMS(64) phase_merge<2>(p, l, 128 + (item >> 4), item & 15, smem); } }
      xcd_barrier(xb);
    }
    REPS(1) {
      { CParams& p = kparams();
        FOR_TILES(128, 8, 8, 8) phase_proj_res(p, l, tm, tn, smem, p.merged, 1024, p.WoT + (size_t)l * DM * DM, 2048, rep == 0 ? 1.f : 0.f);
        if (l == 0 && rep == 0) { FOR_ITEMS(128) phase_proj_res_ctx(p, l, item, smem, p.merged, 1024, p.WoT + (size_t)l * DM * DM, 2048); } }
      xcd_barrier(xb);
    }
    REPS(6) {
      { CParams& p = kparams(); FOR_ITEMS(4224) phase_modulate(p, l, 1, item); }
      xcd_barrier(xb);
    }
    REPS(9) {
      { CParams& p = kparams();
        FOR_TILES(128, 16, 4, 16) phase_mlp1_big(p, l, tm, tn, smem);
        if (l == 0) { FOR_ITEMS(128) phase_mlp1(p, l, 128 + (item >> 5), item & 31, smem); } }
      xcd_barrier(xb);
    }
    REPS(1) {
      { CParams& p = kparams();
        FOR_TILES(128, 8, 8, 8) phase_proj_res(p, l, tm, tn, smem, p.hidden, 4096, p.W2T + (size_t)l * DM * DFF, 5120, rep == 0 ? 1.f : 0.f);
        if (l == 0 && rep == 0) { FOR_ITEMS(128) phase_proj_res_ctx(p, l, item, smem, p.hidden, 4096, p.W2T + (size_t)l * DM * DFF, 5120); } }
      xcd_barrier(xb);
    }
  }
  if (PROBE_DUP == 7) { for (int i = 0; i < 10; i++) xcd_barrier(xb); }
  { CParams& p = kparams(); FOR_ITEMS(4096) phase_final(p, item); }
}

extern "C" void kernel_launch(void* const* d_in, const int* in_sizes, int n_in, void* d_out, int out_size,
                              void* d_ws, size_t ws_size, hipStream_t stream) {
  Params p{};
  const float** fp = (const float**)&p;
  for (int i = 0; i < 31; i++) fp[i] = (const float*)d_in[i];
  p.out = (float*)d_out;
  char* w = (char*)d_ws;
  size_t off = 0;
  auto take = [&](size_t bytes) { char* r = w + off; off += (bytes + 255) & ~(size_t)255; return r; };
  p.WinT = (bf16_t*)take((size_t)2 * 1280 * 1024 * 2);
  p.WgT = (bf16_t*)take((size_t)2 * 4096 * 1024 * 2);
  p.WbT = (bf16_t*)take((size_t)2 * 4 * 1024 * 256 * 2);
  p.WoT = (bf16_t*)take((size_t)2 * 1024 * 1024 * 2);
  p.W1T = (bf16_t*)take((size_t)2 * 4096 * 1024 * 2);
  p.W2T = (bf16_t*)take((size_t)2 * 4096 * 1024 * 2);
  p.WgluT = (bf16_t*)take((size_t)2 * 65536 * 2);
  p.WfnT = (bf16_t*)take((size_t)2 * 65536 * 2);
  p.WcvT = (bf16_t*)take((size_t)2 * 65536 * 2);
  p.xc = (float*)take((size_t)512 * 1024 * 4);
  p.hbuf = (bf16_t*)take((size_t)NTOK * 1024 * 2);
  p.modp = (float*)take((size_t)16 * 2 * 3 * 6144 * 4);
  p.mod = (float*)take((size_t)2 * 3 * 6144 * 4);
  p.Apar = (float2*)take((size_t)4096 * 8);
  p.Bbar = (float2*)take((size_t)4096 * 16 * 8);
  p.E = (float2*)take((size_t)NCHUNK * 2 * 1024 * 8);
  p.Hin = (float2*)take((size_t)NCHUNK * 2 * 1024 * 8);
  p.tw = (float2*)take((size_t)8192 * 8);
  p.H3 = (bf16_t*)take((size_t)8192 * 2);
  p.F1m = (bf16_t*)take((size_t)65536 * 2);
  p.Gm = (bf16_t*)take((size_t)16384 * 2);
  char* R = take((size_t)NTOK * 4096 * 2);
  p.hidden = (bf16_t*)R;
  size_t zsz = (size_t)NTOK * 256 * 4;
  p.zs5 = (float*)R;
  p.zfn = (float*)(R + zsz);
  p.zpl = (float*)(R + 2 * zsz);
  p.zv = (float*)(R + 3 * zsz);
  p.merged = (bf16_t*)R;
  p.out1 = (float2*)(R + 4 * zsz);
  p.ZT = (bf16_t*)(R + 4 * zsz);

  p.zfnP = (bf16_t*)(R + zsz);
  p.br = (bf16_t*)(R + 4 * zsz);
  size_t ysz = (size_t)NTOK * 256 * 2;
  p.ys = (bf16_t*)(R + 6 * zsz);
  p.yfn = (bf16_t*)(R + 6 * zsz + ysz);
  p.cv = (bf16_t*)(R + 6 * zsz + 2 * ysz);
  p.YT0 = (bf16_t*)(R + 6 * zsz + 3 * ysz);
  p.YT1 = (bf16_t*)take((size_t)64 * 128 * 256 * 2 * 2);
  p.bar = (unsigned*)take((size_t)XCD_BAR_WORDS * 4);
  if (off > ws_size) { fprintf(stderr, "workspace too small: need %zu have %zu\n", off, ws_size); return; }

  static int grid_blocks = 0;
  if (!grid_blocks) {
    int dev = 0, cus = 0, per_cu = 0;
    hipGetDevice(&dev);
    hipDeviceGetAttribute(&cus, hipDeviceAttributeMultiprocessorCount, dev);
    hipOccupancyMaxActiveBlocksPerMultiprocessor(&per_cu, fwd_megakernel, 256, 0);
    if (per_cu > 2) per_cu = 2;
    grid_blocks = cus * per_cu;
  }
  hipMemsetAsync(p.bar, 0, (size_t)XCD_BAR_WORDS * 4, stream);
  void* args[] = {&p};
  hipError_t e = hipLaunchCooperativeKernel((void*)fwd_megakernel, dim3(grid_blocks), dim3(256), args, 0, stream);
  if (e != hipSuccess) fprintf(stderr, "cooperative launch failed: %s (grid %d)\n", hipGetErrorString(e), grid_blocks);
}
```
